# Optimizing an MI355X kernel written in HIP

```python
import jax, jax.numpy as jnp
from jax import lax
import numpy as np

D_MODEL = 1024
BATCH = 8
SEQ = 4096
DEPTH = 2

N_A_LAYERS = DEPTH // 2
N_B_LAYERS = DEPTH - N_A_LAYERS
M_HEADS = 4
M_DV = D_MODEL // M_HEADS
M_DK = M_DV // 2
M_CHUNK = 64
GATE_CAP = 15.0
M_QK_W = M_HEADS * M_DK
M_V_W = M_HEADS * M_DV
M_IN_COLS = 2 * M_QK_W + 2 * M_V_W + 2 * M_HEADS
M_SPLITS = [M_QK_W, 2 * M_QK_W, 2 * M_QK_W + M_V_W, 2 * M_QK_W + 2 * M_V_W, 2 * M_QK_W + 2 * M_V_W + M_HEADS]
A_HEAD_DIM = 64
A_Q_HEADS = D_MODEL // A_HEAD_DIM
A_KV_HEADS = 4
A_GROUP = A_Q_HEADS // A_KV_HEADS
WINDOW = 128
ROPE_DIM = A_HEAD_DIM // 4
ROPE_THETA = 500000.0
D_FF = 4 * D_MODEL
PLE_DIM = 256
LN_EPS = 1e-5
DEEPNORM_ALPHA = (2 * DEPTH) ** 0.25
DEEPNORM_BETA = (8 * DEPTH) ** -0.25

kernel_name = "yoco_mlstm_swa_sink_hybrid"


def layer_norm(x, g, b):
    xf = x.astype(jnp.float32)
    mu = jnp.mean(xf, axis=-1, keepdims=True)
    var = jnp.mean(jnp.square(xf - mu), axis=-1, keepdims=True)
    return ((xf - mu) * lax.rsqrt(var + LN_EPS) * g + b).astype(x.dtype)


def partial_rope(t, pos):
    half = ROPE_DIM // 2
    inv_freq = jnp.power(ROPE_THETA, -jnp.arange(half, dtype=jnp.float32) * (2.0 / ROPE_DIM))
    ang = pos.astype(jnp.float32)[..., None] * inv_freq
    cos = jnp.cos(ang)[:, :, None, :]
    sin = jnp.sin(ang)[:, :, None, :]
    tr = t[..., :ROPE_DIM].astype(jnp.float32)
    t1, t2 = tr[..., :half], tr[..., half:]
    rot = jnp.concatenate([t1 * cos - t2 * sin, t2 * cos + t1 * sin], axis=-1).astype(t.dtype)
    return jnp.concatenate([rot, t[..., ROPE_DIM:]], axis=-1)


def soft_cap(g):
    return GATE_CAP * jnp.tanh(g / GATE_CAP)


def to_chunks(t, nc):
    t = t.reshape(t.shape[0], nc, M_CHUNK, *t.shape[2:])
    return jnp.moveaxis(t, (1, 3), (0, 2))


def mlstm_chunkwise(q, k, v, ig, lf):
    B, S, H, DK = q.shape
    DV = v.shape[-1]
    nc = S // M_CHUNK
    xs = tuple(to_chunks(t, nc) for t in (q, k, v, ig, lf))
    causal = jnp.tril(jnp.ones((M_CHUNK, M_CHUNK), dtype=bool))
    init = (jnp.zeros((B, H, DK, DV), jnp.float32),
            jnp.zeros((B, H, DK), jnp.float32),
            jnp.zeros((B, H), jnp.float32))

    def step(carry, chunk):
        C, n, m = carry
        qc, kc, vc, igc, lfc = chunk
        b = jnp.cumsum(lfc, axis=-1)
        log_d = b[..., :, None] - b[..., None, :] + igc[..., None, :]
        log_d = jnp.where(causal, log_d, -jnp.inf)
        log_inter = b + m[..., None]
        m_t = jnp.maximum(jnp.max(log_d, axis=-1), log_inter)
        d = jnp.exp(log_d - m_t[..., None])
        inter = jnp.exp(log_inter - m_t)
        s = jnp.einsum('bhtk,bhsk->bhts', qc, kc) * d
        num = jnp.einsum('bhts,bhsv->bhtv', s, vc) + inter[..., None] * jnp.einsum('bhtk,bhkv->bhtv', qc, C)
        den = jnp.sum(s, axis=-1) + inter * jnp.einsum('bhtk,bhk->bht', qc, n)
        h = num / jnp.maximum(jnp.abs(den), jnp.exp(-m_t))[..., None]
        b_last = b[..., -1]
        a = b_last[..., None] - b + igc
        m_new = jnp.maximum(b_last + m, jnp.max(a, axis=-1))
        w = jnp.exp(a - m_new[..., None])
        decay = jnp.exp(b_last + m - m_new)
        C_new = decay[..., None, None] * C + jnp.einsum('bhs,bhsk,bhsv->bhkv', w, kc, vc)
        n_new = decay[..., None] * n + jnp.einsum('bhs,bhsk->bhk', w, kc)
        return (C_new, n_new, m_new), h

    _, h = lax.scan(step, init, xs)
    return jnp.moveaxis(h, (0, 2), (1, 3)).reshape(B, S, H, DV)


def mlstm_mixer(x, w_in, b_ig, b_fg, head_g, w_out):
    B, S, _ = x.shape
    proj = x @ w_in
    q, k, v, o, ig, fg = jnp.split(proj, M_SPLITS, axis=-1)
    q = q.reshape(B, S, M_HEADS, M_DK).astype(jnp.float32) * (M_DK ** -0.5)
    k = k.reshape(B, S, M_HEADS, M_DK).astype(jnp.float32)
    v = v.reshape(B, S, M_HEADS, M_DV).astype(jnp.float32)
    log_i = soft_cap(ig.astype(jnp.float32) + b_ig)
    log_f = jax.nn.log_sigmoid(soft_cap(fg.astype(jnp.float32) + b_fg))
    h = mlstm_chunkwise(q, k, v, log_i, log_f)
    mu = jnp.mean(h, axis=-1, keepdims=True)
    var = jnp.mean(jnp.square(h - mu), axis=-1, keepdims=True)
    h = (h - mu) * lax.rsqrt(var + LN_EPS) * head_g.reshape(M_HEADS, M_DV)
    h = h.reshape(B, S, D_MODEL).astype(x.dtype)
    return (jax.nn.sigmoid(o) * h) @ w_out


def shared_kv(x, pos, kv_w, kv_b):
    B, S, _ = x.shape
    kv = x @ kv_w + kv_b
    k, v = jnp.split(kv, 2, axis=-1)
    k = partial_rope(k.reshape(B, S, A_KV_HEADS, A_HEAD_DIM), pos)
    v = v.reshape(B, S, A_KV_HEADS, A_HEAD_DIM)
    return k, v


def banded(t, nb):
    t = t.reshape(t.shape[0], nb, WINDOW, A_KV_HEADS, A_HEAD_DIM)
    prev = jnp.pad(t, ((0, 0), (1, 0), (0, 0), (0, 0), (0, 0)))[:, :-1]
    return jnp.concatenate([prev, t], axis=2)


def swa_sink_attention(x, pos, k_sh, v_sh, w_q, b_q, sinks, w_o, b_o):
    B, S, _ = x.shape
    nb = S // WINDOW
    q = partial_rope((x @ w_q + b_q).reshape(B, S, A_Q_HEADS, A_HEAD_DIM), pos)
    q = q.reshape(B, nb, WINDOW, A_KV_HEADS, A_GROUP, A_HEAD_DIM)
    kb, vb = banded(k_sh, nb), banded(v_sh, nb)
    scores = jnp.einsum('bnqkgd,bnskd->bnkgqs', q, kb).astype(jnp.float32) * (A_HEAD_DIM ** -0.5)
    qi = jnp.arange(WINDOW)[:, None]
    si = jnp.arange(2 * WINDOW)[None, :]
    diff = qi + WINDOW - si
    band = (diff >= 0) & (diff < WINDOW)
    blk = jnp.arange(nb)[:, None, None]
    valid = band[None] & (blk * WINDOW - WINDOW + si[None] >= 0)
    scores = jnp.where(valid[None, :, None, None], scores, -jnp.inf)
    sink = sinks.astype(jnp.float32).reshape(A_KV_HEADS, A_GROUP)[None, None, :, :, None]
    m = jnp.maximum(jnp.max(scores, axis=-1), sink)
    e = jnp.exp(scores - m[..., None])
    probs = e / (jnp.sum(e, axis=-1) + jnp.exp(sink - m))[..., None]
    out = jnp.einsum('bnkgqs,bnskd->bnqkgd', probs.astype(x.dtype), vb).reshape(B, S, D_MODEL)
    return out @ w_o + b_o


def squared_relu_mlp(x, w_up, w_down):
    return jnp.square(jax.nn.relu(x @ w_up)) @ w_down


def setup_inputs(seed: int = 0) -> dict:
    key = jax.random.key(seed)
    ks = jax.random.split(key, 24)
    f32 = jnp.float32
    nrm = lambda k, shape, scale: jax.random.normal(k, shape, f32) * scale
    x = jax.random.normal(ks[0], (BATCH, SEQ, D_MODEL), f32)
    p = jax.random.normal(ks[1], (DEPTH, BATCH, SEQ, PLE_DIM), f32)
    start = jax.random.randint(ks[2], (BATCH, 1), 0, 1024, dtype=jnp.int32)
    positions = (start + jnp.arange(SEQ, dtype=jnp.int32)[None, :]).astype(jnp.int32)
    a_w_in = nrm(ks[3], (N_A_LAYERS, D_MODEL, M_IN_COLS), D_MODEL ** -0.5)
    a_b_igate = nrm(ks[4], (N_A_LAYERS, M_HEADS), 0.1)
    a_b_fgate = jnp.linspace(3.0, 6.0, M_HEADS, dtype=f32)[None, :] + nrm(ks[5], (N_A_LAYERS, M_HEADS), 0.1)
    a_head_norm_g = 1.0 + nrm(ks[6], (N_A_LAYERS, D_MODEL), 0.02)
    a_w_out = nrm(ks[7], (N_A_LAYERS, D_MODEL, D_MODEL), D_MODEL ** -0.5 * DEEPNORM_BETA)
    kv_w = nrm(ks[8], (D_MODEL, 2 * A_KV_HEADS * A_HEAD_DIM), D_MODEL ** -0.5)
    kv_b = nrm(ks[9], (2 * A_KV_HEADS * A_HEAD_DIM,), 0.02)
    b_w_q = nrm(ks[10], (N_B_LAYERS, D_MODEL, A_Q_HEADS * A_HEAD_DIM), D_MODEL ** -0.5)
    b_b_q = nrm(ks[11], (N_B_LAYERS, A_Q_HEADS * A_HEAD_DIM), 0.02)
    b_sinks = nrm(ks[12], (N_B_LAYERS, A_Q_HEADS), 0.5)
    b_w_o = nrm(ks[13], (N_B_LAYERS, A_Q_HEADS * A_HEAD_DIM, D_MODEL), D_MODEL ** -0.5 * DEEPNORM_BETA)
    b_b_o = nrm(ks[14], (N_B_LAYERS, D_MODEL), 0.02)
    mix_ln_g = 1.0 + nrm(ks[15], (DEPTH, D_MODEL), 0.02)
    mix_ln_b = nrm(ks[16], (DEPTH, D_MODEL), 0.02)
    mlp_w_up = nrm(ks[17], (DEPTH, D_MODEL, D_FF), D_MODEL ** -0.5)
    mlp_w_down = nrm(ks[18], (DEPTH, D_FF, D_MODEL), D_FF ** -0.5 * DEEPNORM_BETA)
    mlp_ln_g = 1.0 + nrm(ks[19], (DEPTH, D_MODEL), 0.02)
    mlp_ln_b = nrm(ks[20], (DEPTH, D_MODEL), 0.02)
    ple_w_gate = nrm(ks[21], (DEPTH, D_MODEL, D_MODEL), D_MODEL ** -0.5)
    ple_b_gate = nrm(ks[22], (DEPTH, D_MODEL), 0.02)
    ple_w_proj = nrm(ks[23], (DEPTH, PLE_DIM, D_MODEL), PLE_DIM ** -0.5 * DEEPNORM_BETA)
    return {"x": x, "p": p, "positions": positions,
            "a_w_in": a_w_in, "a_b_igate": a_b_igate, "a_b_fgate": a_b_fgate,
            "a_head_norm_g": a_head_norm_g, "a_w_out": a_w_out,
            "kv_w": kv_w, "kv_b": kv_b,
            "b_w_q": b_w_q, "b_b_q": b_b_q, "b_sinks": b_sinks, "b_w_o": b_w_o, "b_b_o": b_b_o,
            "mix_ln_g": mix_ln_g, "mix_ln_b": mix_ln_b,
            "mlp_w_up": mlp_w_up, "mlp_w_down": mlp_w_down, "mlp_ln_g": mlp_ln_g, "mlp_ln_b": mlp_ln_b,
            "ple_w_gate": ple_w_gate, "ple_b_gate": ple_b_gate, "ple_w_proj": ple_w_proj}


def reference(x, p, positions, a_w_in, a_b_igate, a_b_fgate, a_head_norm_g, a_w_out,
              kv_w, kv_b, b_w_q, b_b_q, b_sinks, b_w_o, b_b_o,
              mix_ln_g, mix_ln_b, mlp_w_up, mlp_w_down, mlp_ln_g, mlp_ln_b,
              ple_w_gate, ple_b_gate, ple_w_proj):
    k_sh, v_sh = None, None
    for i in range(DEPTH):
        if i < N_A_LAYERS:
            mix = mlstm_mixer(x, a_w_in[i], a_b_igate[i], a_b_fgate[i], a_head_norm_g[i], a_w_out[i])
        else:
            if i == N_A_LAYERS:
                k_sh, v_sh = shared_kv(x, positions, kv_w, kv_b)
            j = i - N_A_LAYERS
            mix = swa_sink_attention(x, positions, k_sh, v_sh, b_w_q[j], b_b_q[j], b_sinks[j], b_w_o[j], b_b_o[j])
        x = layer_norm(DEEPNORM_ALPHA * x + mix, mix_ln_g[i], mix_ln_b[i])
        x = layer_norm(DEEPNORM_ALPHA * x + squared_relu_mlp(x, mlp_w_up[i], mlp_w_down[i]), mlp_ln_g[i], mlp_ln_b[i])
        x = x + jax.nn.sigmoid(x @ ple_w_gate[i] + ple_b_gate[i]) * (p[i] @ ple_w_proj[i])
    return x
```

```cpp
#include <hip/hip_runtime.h>
#include <cstdio>
#include <cstdint>

typedef unsigned short bf16_t;
typedef float f32x4 __attribute__((ext_vector_type(4)));

namespace cfg {
constexpr int D = 1024, NB = 8, S = 4096, M = NB * S;
constexpr int MH = 4, MDV = 256, MDK = 128, NIN = 3072, LDW_IN = 3080;
constexpr int AH = 16, AKV = 4, AHD = 64, WIN = 128, NQKV = 1536;
constexpr int FF = 4096, PLE = 256;
constexpr float LN_EPS = 1e-5f;
constexpr float ALPHA = 1.41421356237309515f;
constexpr float GATE_CAP = 15.0f;
constexpr size_t MiB = 1u << 20;
constexpr size_t WS_CTL = 0;
constexpr size_t WS_GATES = 1 * MiB;
constexpr size_t WS_CS = 2 * MiB;
constexpr size_t WS_BQKV = 56 * MiB;
constexpr size_t WS_W = 4 * MiB;
constexpr size_t W_IN = WS_W;
constexpr size_t W_OUT = W_IN + 6 * MiB;
constexpr size_t W_UP0 = W_OUT + 2 * MiB;
constexpr size_t W_DN0 = W_UP0 + 8 * MiB;
constexpr size_t W_G0 = W_DN0 + 8 * MiB;
constexpr size_t W_P0 = W_G0 + 2 * MiB;
constexpr size_t W_QKV = W_P0 + MiB / 2;
constexpr size_t W_O = W_QKV + 3 * MiB;
constexpr size_t W_UP1 = W_O + 2 * MiB;
constexpr size_t W_DN1 = W_UP1 + 8 * MiB;
constexpr size_t W_G1 = W_DN1 + 8 * MiB;
constexpr size_t W_P1 = W_G1 + 2 * MiB;
constexpr size_t WS_XB = 64 * MiB;
constexpr size_t WS_U = 128 * MiB;
constexpr size_t WS_PB = 192 * MiB;
constexpr size_t WS_ST = 224 * MiB;
constexpr size_t WS_HH = 256 * MiB;
constexpr size_t WS_QKVO = WS_HH;
constexpr size_t WS_HB = WS_HH + 192 * MiB;
constexpr size_t WS_X3B = WS_HH;
constexpr size_t WS_QKV1 = WS_HH + 64 * MiB;
constexpr size_t WS_OB = WS_HH + 192 * MiB;
constexpr size_t WS_END = 512 * MiB;
}
using namespace cfg;

__device__ __forceinline__ float bf2f(bf16_t v) { return __uint_as_float((unsigned)v << 16); }
__device__ __forceinline__ bf16_t f2bf(float f) { unsigned u = __float_as_uint(f); return (bf16_t)((u + 0x7fffu + ((u >> 16) & 1u)) >> 16); }
__device__ __forceinline__ float sigmoidf_(float z) { return 1.f / (1.f + expf(-z)); }

namespace pg8 {
#define PG8_LAS __attribute__((address_space(3)))
typedef unsigned short bf16_t;
typedef short bf16x8 __attribute__((ext_vector_type(8)));
typedef float f32x4 __attribute__((ext_vector_type(4)));
typedef unsigned u32x4 __attribute__((ext_vector_type(4)));
constexpr int BM = 256, BK = 64, HALF = 128, HTB = HALF * BK * 2  , STAGE_BYTES = 8 * HTB, NXCD = 8, WGM = 8;

__host__ __device__ __forceinline__ int lds_byte(int r, int c) { const int st = (r >> 4) * 2 + (c >> 5), rr = r & 15, cc = c & 31, ob = rr * 64 + cc * 2; return st * 1024 + (ob ^ (((ob >> 9) & 1) << 5)); }
__host__ __device__ __forceinline__ void stage_rc(int b, int& R, int& C) { const int st = b / 1024, sb = b % 1024, swz = sb ^ (((sb >> 9) & 1) << 5); R = (st >> 1) * 16 + swz / 64; C = (st & 1) * 32 + (swz % 64) / 2; }
__host__ __device__ __forceinline__ int perm32(int rho) { const int n = rho >> 4, i = rho & 15; return 8 * (i >> 2) + 4 * n + (i & 3); }

struct Unit { int pm, pn; };
struct Gemm { const bf16_t* A; const bf16_t* Bt; int M, N, K, pad; };

struct StaticOrder {
    int nM, nN, nwg, G, c;
    __host__ __device__ void init(int M, int N, int G_, int c_) { nM = M / BM; nN = N / BM; nwg = nM * nN; G = G_; c = c_; }
    __host__ __device__ bool next(int i, Unit& u) const {
        const long L = (long)i * G + c; if (L >= nwg) return false;
        int wgid = (int)L; { const int q = nwg / NXCD, r = nwg % NXCD, xcd = wgid % NXCD, off = wgid / NXCD; wgid = (xcd < r ? xcd * (q + 1) : r * (q + 1) + (xcd - r) * q) + off; }
        const int nig = WGM * nN, gid = wgid / nig, fm = gid * WGM, gsz = (nM - fm) < WGM ? (nM - fm) : WGM;
        u.pm = fm + ((wgid % nig) % gsz); u.pn = (wgid % nig) / gsz; return true;
    }
    __device__ __forceinline__ void a_ready(const Unit&) const {}
    __device__ __forceinline__ void done(const Unit&) const {}
};

template <class Epi, class Sched, bool ALIGN_EPI = false, bool SP2 = false>
__device__ __forceinline__ void gemm_phase(PG8_LAS unsigned char* lds, const Gemm g, const Sched& S, const Epi& E) {
    const int tid = threadIdx.x, wid = __builtin_amdgcn_readfirstlane(tid >> 6), lane = tid & 63, wr = wid >> 2, wc = wid & 3, fr = lane & 15, fq = lane >> 4;
    const int K = g.K, nt = K / BK;
    unsigned voffA[2], voffB[2];
#pragma unroll
    for (int i = 0; i < 2; ++i) { int R, C; stage_rc(tid * 16 + i * 8192, R, C); const int Rb = Epi::PERM ? ((R & ~31) + perm32(R & 31)) : R;
        voffA[i] = (unsigned)(R * K + C) * 2u; voffB[i] = (unsigned)(Rb * K + C) * 2u; }
    const size_t kstep = (size_t)(BK * 2);
    const size_t hstep = (size_t)HALF * K * 2;
    const size_t tstep = 2 * hstep;
    const unsigned ldsw = (unsigned)wid * 1024u;
    const int aoff = lds_byte(wr * 64 + fr, fq * 8), boff = lds_byte(wc * 32 + fr, fq * 8);
#define PG8_SA(b, h) (((b) * 2 + (h)) * HTB)
#define PG8_SB(b, h) ((4 + (b) * 2 + (h)) * HTB)
#define PG8_STAGE(bufoff, gbase, voff) do { _Pragma("unroll") for (int _i = 0; _i < 2; ++_i) \
        __builtin_amdgcn_global_load_lds((const unsigned*)((const char*)(gbase) + (voff)[_i]), (PG8_LAS unsigned*)(lds + (bufoff) + ldsw + _i * 8192), 16, 0, 0); } while (0)
#define PG8_LDA(dst, b, h) do { _Pragma("unroll") for (int m = 0; m < 4; ++m) _Pragma("unroll") for (int k = 0; k < 2; ++k) dst[m][k] = *(const PG8_LAS bf16x8*)(lds + PG8_SA(b, h) + aoff + m * 2048 + k * 1024); } while (0)
#define PG8_LDB(dst, b, h) do { _Pragma("unroll") for (int n = 0; n < 2; ++n) _Pragma("unroll") for (int k = 0; k < 2; ++k) dst[n][k] = *(const PG8_LAS bf16x8*)(lds + PG8_SB(b, h) + boff + n * 2048 + k * 1024); } while (0)
#define PG8_MMA(ai, bj, At, Bt) do { __builtin_amdgcn_s_setprio(1); _Pragma("unroll") for (int m = 0; m < 4; ++m) _Pragma("unroll") for (int n = 0; n < 2; ++n) _Pragma("unroll") for (int k = 0; k < 2; ++k) \
        acc[ai][bj][m][n] = __builtin_amdgcn_mfma_f32_16x16x32_bf16(Bt[n][k], At[m][k], acc[ai][bj][m][n], 0, 0, 0); __builtin_amdgcn_s_setprio(0); } while (0)
#define PG8_WAIT_V(n) asm volatile("s_waitcnt vmcnt(" #n ")" ::: "memory")
#define PG8_WAIT_L(n) asm volatile("s_waitcnt lgkmcnt(" #n ")" ::: "memory")
#define PG8_BAR __builtin_amdgcn_s_barrier()
#define PG8_SCHED __builtin_amdgcn_sched_barrier(0)
    Unit cur, nxt; int ui = 0;
    if (!S.next(0, cur)) return;
    f32x4 acc[2][2][4][2];
#pragma unroll
    for (int a = 0; a < 2; ++a)
#pragma unroll
        for (int b = 0; b < 2; ++b)
#pragma unroll
            for (int m = 0; m < 4; ++m)
#pragma unroll
                for (int n = 0; n < 2; ++n) acc[a][b][m][n] = (f32x4){0.f, 0.f, 0.f, 0.f};
    bf16x8 At[4][2], B0[2][2], B1[2][2];
    const char* cA = (const char*)g.A + (size_t)cur.pm * tstep; const char* cB = (const char*)g.Bt + (size_t)cur.pn * tstep;
    S.a_ready(cur);
    if constexpr (SP2) {
        PG8_STAGE(PG8_SB(0, 0), cB, voffB); PG8_STAGE(PG8_SB(0, 1), cB + hstep, voffB); PG8_STAGE(PG8_SA(0, 0), cA, voffA); PG8_STAGE(PG8_SA(0, 1), cA + hstep, voffA);
        if (wr == 1) PG8_BAR;
        PG8_WAIT_V(2); PG8_BAR;
        PG8_STAGE(PG8_SB(1, 0), cB + kstep, voffB); PG8_STAGE(PG8_SA(1, 0), cA + kstep, voffA); PG8_STAGE(PG8_SB(1, 1), cB + hstep + kstep, voffB);
        PG8_WAIT_V(6); PG8_BAR;
    } else {
        PG8_STAGE(PG8_SB(0, 0), cB, voffB); PG8_STAGE(PG8_SA(0, 0), cA, voffA); PG8_STAGE(PG8_SB(0, 1), cB + hstep, voffB); PG8_STAGE(PG8_SA(0, 1), cA + hstep, voffA);
        if (wr == 1) PG8_BAR;
        PG8_WAIT_V(4); PG8_BAR;
        PG8_STAGE(PG8_SB(1, 0), cB + kstep, voffB); PG8_STAGE(PG8_SA(1, 0), cA + kstep, voffA); PG8_STAGE(PG8_SB(1, 1), cB + hstep + kstep, voffB);
        PG8_WAIT_V(6); PG8_BAR;
    }
    for (;;) {
        const bool has_next = S.next(ui + 1, nxt);
        const char* nA = has_next ? (const char*)g.A + (size_t)nxt.pm * tstep : cA; const char* nB = has_next ? (const char*)g.Bt + (size_t)nxt.pn * tstep : cB;
        for (int t = 0; t < nt; t += 2) {
            const bool last = (t == nt - 2);
            const char* a1 = cA + (size_t)(t + 1) * kstep;
            const char* a2 = last ? nA : cA + (size_t)(t + 2) * kstep; const char* b2 = last ? nB : cB + (size_t)(t + 2) * kstep;
            const char* a3 = a2 + kstep; const char* b3 = b2 + kstep;
            if (last && has_next) S.a_ready(nxt);
            if constexpr (SP2) {
            PG8_LDB(B0, 0, 0); PG8_LDB(B1, 0, 1); PG8_SCHED; PG8_LDA(At, 0, 0); PG8_STAGE(PG8_SA(1, 1), a1 + hstep, voffA);
            PG8_WAIT_V(8); PG8_WAIT_L(0); PG8_BAR; PG8_MMA(0, 0, At, B0); PG8_MMA(0, 1, At, B1); PG8_BAR; PG8_SCHED;
            PG8_LDA(At, 0, 1); PG8_STAGE(PG8_SB(0, 0), b2, voffB); PG8_STAGE(PG8_SB(0, 1), b2 + hstep, voffB); PG8_STAGE(PG8_SA(0, 0), a2, voffA);
            PG8_WAIT_V(8); PG8_WAIT_L(0); PG8_BAR; PG8_MMA(1, 0, At, B0); PG8_MMA(1, 1, At, B1); PG8_BAR; PG8_SCHED;
            PG8_LDB(B0, 1, 0); PG8_LDB(B1, 1, 1); PG8_SCHED; PG8_LDA(At, 1, 0); PG8_STAGE(PG8_SA(0, 1), a2 + hstep, voffA);
            PG8_WAIT_V(8); PG8_WAIT_L(0); PG8_BAR; PG8_MMA(0, 0, At, B0); PG8_MMA(0, 1, At, B1); PG8_BAR; PG8_SCHED;
            PG8_LDA(At, 1, 1); PG8_STAGE(PG8_SB(1, 0), b3, voffB); PG8_STAGE(PG8_SB(1, 1), b3 + hstep, voffB); PG8_STAGE(PG8_SA(1, 0), a3, voffA);
            PG8_WAIT_V(8); PG8_WAIT_L(0); PG8_BAR; PG8_MMA(1, 0, At, B0); PG8_MMA(1, 1, At, B1); PG8_BAR; PG8_SCHED;
            } else {
            PG8_LDB(B0, 0, 0); PG8_SCHED; PG8_LDA(At, 0, 0); PG8_STAGE(PG8_SA(1, 1), a1 + hstep, voffA);
            PG8_WAIT_L(8); PG8_BAR; PG8_WAIT_L(0); PG8_MMA(0, 0, At, B0); PG8_BAR; PG8_SCHED;
            PG8_LDB(B1, 0, 1); PG8_STAGE(PG8_SB(0, 0), b2, voffB);
            PG8_BAR; PG8_WAIT_L(0); PG8_MMA(0, 1, At, B1); PG8_BAR;
            PG8_LDA(At, 0, 1); PG8_STAGE(PG8_SA(0, 0), a2, voffA);
            PG8_BAR; PG8_WAIT_L(0); PG8_MMA(1, 0, At, B0); PG8_BAR; PG8_SCHED;
            PG8_STAGE(PG8_SB(0, 1), b2 + hstep, voffB);
            PG8_WAIT_V(6); PG8_BAR; PG8_MMA(1, 1, At, B1); PG8_BAR;
            PG8_LDB(B0, 1, 0); PG8_SCHED; PG8_LDA(At, 1, 0); PG8_STAGE(PG8_SA(0, 1), a2 + hstep, voffA);
            PG8_WAIT_L(8); PG8_BAR; PG8_WAIT_L(0); PG8_MMA(0, 0, At, B0); PG8_BAR; PG8_SCHED;
            PG8_LDB(B1, 1, 1); PG8_STAGE(PG8_SB(1, 0), b3, voffB);
            PG8_BAR; PG8_WAIT_L(0); PG8_MMA(0, 1, At, B1); PG8_BAR;
            PG8_LDA(At, 1, 1); PG8_STAGE(PG8_SA(1, 0), a3, voffA);
            PG8_BAR; PG8_WAIT_L(0); PG8_MMA(1, 0, At, B0); PG8_BAR; PG8_SCHED;
            PG8_STAGE(PG8_SB(1, 1), b3 + hstep, voffB);
            PG8_WAIT_V(6); PG8_BAR; PG8_MMA(1, 1, At, B1); PG8_BAR;
            }
        }
        if constexpr (ALIGN_EPI) { if (wr == 0) PG8_BAR; }
        if constexpr (!Epi::AFTER_DRAIN) { E(acc, cur, wr, wc, fr, fq); S.done(cur); }
        if (!has_next) break;
#pragma unroll
        for (int a = 0; a < 2; ++a)
#pragma unroll
            for (int b = 0; b < 2; ++b)
#pragma unroll
                for (int m = 0; m < 4; ++m)
#pragma unroll
                    for (int n = 0; n < 2; ++n) acc[a][b][m][n] = (f32x4){0.f, 0.f, 0.f, 0.f};
        cur = nxt; cA = nA; cB = nB; ++ui;
        if constexpr (ALIGN_EPI) { if (wr == 1) PG8_BAR; }
    }
    PG8_WAIT_V(0);
    if constexpr (!ALIGN_EPI) { if (wr == 0) PG8_BAR; }
    PG8_BAR;
    if constexpr (Epi::AFTER_DRAIN) { E.fused(acc, cur, wr, wc, fr, fq, lds, wid, lane); S.done(cur); }
#undef PG8_SA
#undef PG8_SB
#undef PG8_STAGE
#undef PG8_LDA
#undef PG8_LDB
#undef PG8_MMA
#undef PG8_WAIT_V
#undef PG8_WAIT_L
#undef PG8_BAR
#undef PG8_SCHED
}
}
namespace pg8 {
typedef float f32x2 __attribute__((ext_vector_type(2)));
typedef unsigned u32x2 __attribute__((ext_vector_type(2)));
typedef __bf16 bf16x2_t __attribute__((ext_vector_type(2)));
__device__ __forceinline__ unsigned cvtpk(float lo, float hi) { f32x2 v = {lo, hi}; bf16x2_t b = __builtin_convertvector(v, bf16x2_t); return __builtin_bit_cast(unsigned, b); }
__device__ __forceinline__ float fast_sigmoid(float z) { return __builtin_amdgcn_rcpf(1.0f + __builtin_amdgcn_exp2f(-1.4426950408889634f * z)); }
template <int ACT> struct EpiBf16G {
    static constexpr bool PERM = true, AFTER_DRAIN = false;
    bf16_t* O; const float* bias; int ldc, nscale; float scale; int pad;
    __device__ __forceinline__ void operator()(const f32x4 (&acc)[2][2][4][2], const Unit& u, int wr, int wc, int fr, int fq) const {
        const int row0 = u.pm * BM + wr * 64 + fr, col0 = u.pn * BM + wc * 32 + 8 * fq;
        f32x4 bv[2][2]; float sc[2];
#pragma unroll
        for (int bj = 0; bj < 2; ++bj) { sc[bj] = (col0 + bj * HALF < nscale) ? scale : 1.f;
#pragma unroll
            for (int n = 0; n < 2; ++n) bv[bj][n] = bias ? *(const f32x4*)(bias + col0 + bj * HALF + 4 * n) : (f32x4){0.f, 0.f, 0.f, 0.f}; }
#pragma unroll
        for (int ai = 0; ai < 2; ++ai)
#pragma unroll
            for (int m = 0; m < 4; ++m) { bf16_t* rowp = O + (size_t)(row0 + ai * HALF + m * 16) * ldc + col0;
#pragma unroll
                for (int bj = 0; bj < 2; ++bj) { f32x4 v0 = acc[ai][bj][m][0] + bv[bj][0], v1 = acc[ai][bj][m][1] + bv[bj][1];
                    if (ACT == 1) { v0 = __builtin_elementwise_max(v0, (f32x4){0.f, 0.f, 0.f, 0.f}); v1 = __builtin_elementwise_max(v1, (f32x4){0.f, 0.f, 0.f, 0.f}); v0 = v0 * v0; v1 = v1 * v1; }
                    v0 = v0 * sc[bj]; v1 = v1 * sc[bj];
                    u32x4 w; w.x = cvtpk(v0[0], v0[1]); w.y = cvtpk(v0[2], v0[3]); w.z = cvtpk(v1[0], v1[1]); w.w = cvtpk(v1[2], v1[3]);
                    *(u32x4*)(rowp + bj * HALF) = w; } }
    }
};
struct EpiRes {
    static constexpr bool PERM = false, AFTER_DRAIN = false;
    const float* base; float* R; const float* bias; float alpha; int pad;
    __device__ __forceinline__ void operator()(const f32x4 (&acc)[2][2][4][2], const Unit& u, int wr, int wc, int fr, int fq) const {
        const int col0 = u.pn * BM + wc * 32 + 4 * fq;
        f32x4 bv[2][2];
#pragma unroll
        for (int bj = 0; bj < 2; ++bj)
#pragma unroll
            for (int n = 0; n < 2; ++n) bv[bj][n] = bias ? *(const f32x4*)(bias + col0 + bj * HALF + n * 16) : (f32x4){0.f, 0.f, 0.f, 0.f};
#pragma unroll
        for (int ai = 0; ai < 2; ++ai)
#pragma unroll
            for (int m = 0; m < 4; ++m) { const size_t off = (size_t)(u.pm * BM + ai * HALF + wr * 64 + m * 16 + fr) * 1024 + col0;
#pragma unroll
                for (int bj = 0; bj < 2; ++bj)
#pragma unroll
                    for (int n = 0; n < 2; ++n) { const size_t idx = off + bj * HALF + n * 16; const f32x4 b = *(const f32x4*)(base + idx);
                        *(f32x4*)(R + idx) = b * alpha + acc[ai][bj][m][n] + bv[bj][n]; }
                if (m & 1) asm volatile("" ::: "memory"); }
    }
};
struct EpiPle {
    static constexpr bool PERM = false, AFTER_DRAIN = false;
    float* R; const float* bias; const bf16_t* U; bf16_t* Xb;
    __device__ __forceinline__ void operator()(const f32x4 (&acc)[2][2][4][2], const Unit& u, int wr, int wc, int fr, int fq) const {
        const int col0 = u.pn * BM + wc * 32 + 4 * fq;
        f32x4 bv[2][2];
#pragma unroll
        for (int bj = 0; bj < 2; ++bj)
#pragma unroll
            for (int n = 0; n < 2; ++n) bv[bj][n] = *(const f32x4*)(bias + col0 + bj * HALF + n * 16);
#pragma unroll
        for (int ai = 0; ai < 2; ++ai)
#pragma unroll
            for (int m = 0; m < 4; ++m) { const size_t off = (size_t)(u.pm * BM + ai * HALF + wr * 64 + m * 16 + fr) * 1024 + col0;
#pragma unroll
                for (int bj = 0; bj < 2; ++bj)
#pragma unroll
                    for (int n = 0; n < 2; ++n) { const size_t idx = off + bj * HALF + n * 16; const f32x4 r0 = *(const f32x4*)(R + idx); const u32x2 uw = *(const u32x2*)(U + idx);
                        const f32x4 z = acc[ai][bj][m][n] + bv[bj][n];
                        f32x4 uv; uv[0] = __uint_as_float(uw.x << 16); uv[1] = __uint_as_float(uw.x & 0xffff0000u); uv[2] = __uint_as_float(uw.y << 16); uv[3] = __uint_as_float(uw.y & 0xffff0000u);
                        f32x4 r; r[0] = r0[0] + fast_sigmoid(z[0]) * uv[0]; r[1] = r0[1] + fast_sigmoid(z[1]) * uv[1]; r[2] = r0[2] + fast_sigmoid(z[2]) * uv[2]; r[3] = r0[3] + fast_sigmoid(z[3]) * uv[3];
                        *(f32x4*)(R + idx) = r;
                        if (Xb) { u32x2 w; w.x = cvtpk(r[0], r[1]); w.y = cvtpk(r[2], r[3]); *(u32x2*)(Xb + idx) = w; } }
                if (m & 1) asm volatile("" ::: "memory"); }
    }
};
}

#define GAS __attribute__((address_space(1)))
#define LAS __attribute__((address_space(3)))

typedef unsigned v4u __attribute__((ext_vector_type(4)));


typedef GAS unsigned gu32;
typedef GAS unsigned long long gu64;
#define RLX_AGENT __ATOMIC_RELAXED, __HIP_MEMORY_SCOPE_AGENT
#define LDS_WAIT() asm volatile("s_waitcnt lgkmcnt(0)" ::: "memory")
#define VM_WAIT() asm volatile("s_waitcnt vmcnt(0)" ::: "memory")
__device__ __forceinline__ unsigned long long rt() { return __builtin_amdgcn_s_memrealtime(); }

#define XB_TMO      128
#define XB_XCNT(j)  (256  + 64 * (j))
#define XB_XSUB(j)  (1280 + 64 * (j))
#define XB_XGEN(j)  (2304 + 64 * (j))
#define XB_TOP      3328
#define XB_TOPGEN   3392
#define XCD_BAR_WORDS 3456
#define XB_SPIN_CAP (1u << 18)

__device__ __forceinline__ unsigned xb_ld(unsigned* p)              { return __hip_atomic_load(p, __ATOMIC_RELAXED, __HIP_MEMORY_SCOPE_AGENT); }
__device__ __forceinline__ unsigned xb_add(unsigned* p, unsigned v) { return __hip_atomic_fetch_add(p, v, __ATOMIC_RELAXED, __HIP_MEMORY_SCOPE_AGENT); }
__device__ __forceinline__ unsigned xb_xcc_id() { return (unsigned)__builtin_amdgcn_s_getreg((3 << 11) | 20) & 0xFu; }
#define XB_SPIN(cond, bar) do { unsigned _sp = 0; while (cond) { __builtin_amdgcn_s_sleep(1); \
    if ((++_sp & 255u) == 0u) { if (xb_ld(&(bar)[XB_TMO])) break; if (_sp > XB_SPIN_CAP) { atomicAdd(&(bar)[XB_TMO], 1u); break; } } } } while (0)

struct XcdBarrier {
    unsigned* bar; unsigned x;
    volatile LAS unsigned* st;
};

__device__ __forceinline__ XcdBarrier xcd_barrier_post(unsigned* bar, volatile LAS unsigned* st) {
    XcdBarrier b; b.bar = bar; b.x = xb_xcc_id(); b.st = st;
    if (threadIdx.x == 0) (void)xb_add(&bar[XB_XCNT(b.x)], 1u);
    return b;
}
__device__ __forceinline__ void xcd_barrier_complete(unsigned* bar, unsigned x, unsigned& nloc, unsigned& nx) {
    const unsigned G = gridDim.x * gridDim.y * gridDim.z;
    unsigned sum, cnt, mine, sp = 0u;
    for (;;) {
        sum = 0u; cnt = 0u; mine = 0u;
#pragma unroll
        for (unsigned j = 0; j < 16; ++j) { const unsigned c = xb_ld(&bar[XB_XCNT(j)]); sum += c; cnt += (c > 0u) ? 1u : 0u; mine = (j == x) ? c : mine; }
        if (sum == G) break;
        __builtin_amdgcn_s_sleep(1);
        if ((++sp & 255u) == 0u) { if (xb_ld(&bar[XB_TMO])) break; if (sp > XB_SPIN_CAP) { atomicAdd(&bar[XB_TMO], 1u); break; } }
    }
    nloc = mine > 0u ? mine : 1u; nx = cnt > 0u ? cnt : 1u;
}

__device__ __forceinline__ void xcd_barrier(const XcdBarrier& b) {
    asm volatile("s_waitcnt vmcnt(0)" ::: "memory");
    __syncthreads();
    if (threadIdx.x == 0) {
        unsigned* bar = b.bar;
        __builtin_amdgcn_s_waitcnt(0);
        unsigned nloc = b.st[0], nx = b.st[1];
        if (nloc == 0u) { xcd_barrier_complete(bar, b.x, nloc, nx); b.st[0] = nloc; b.st[1] = nx; }
        const unsigned old = xb_add(&bar[XB_XSUB(b.x)], 1u);
        const unsigned gen = old / nloc;
        if (old + 1u == (gen + 1u) * nloc) {
            __builtin_amdgcn_fence(__ATOMIC_RELEASE, "agent");
            asm volatile("s_waitcnt vmcnt(0)" ::: "memory");
            const unsigned og = xb_add(&bar[XB_TOP], 1u);
            const unsigned tg = og / nx;
            if (og + 1u == (tg + 1u) * nx) xb_add(&bar[XB_TOPGEN], 1u);
            else XB_SPIN(xb_ld(&bar[XB_TOPGEN]) == tg, bar);
            __builtin_amdgcn_fence(__ATOMIC_ACQUIRE, "agent");
            xb_add(&bar[XB_XGEN(b.x)], 1u);
            asm volatile("s_waitcnt vmcnt(0)" ::: "memory");
        } else {
            XB_SPIN(xb_ld(&bar[XB_XGEN(b.x)]) == gen, bar);
            __builtin_amdgcn_fence(__ATOMIC_ACQUIRE, "agent");
            asm volatile("s_waitcnt vmcnt(0)" ::: "memory");
        }
    }
    __syncthreads();
}

__device__ __forceinline__ unsigned pk2(float lo, float hi) { return (unsigned)f2bf(lo) | ((unsigned)f2bf(hi) << 16); }
__device__ __forceinline__ float wave_sum(float v) {
#pragma unroll
    for (int o = 1; o < 64; o <<= 1) v += __shfl_xor(v, o);
    return v;
}
__device__ __forceinline__ void p0_transpose_item(const float* W, int K, int N, int ldw, int coff, bf16_t* WT, int row_off, LAS float* scr, int item, int lane) {
    const int nblk = N / 32, kb = item / nblk, nb = item % nblk, k0 = 64 * kb, n0 = 32 * nb;
#pragma unroll 8
    for (int i = 0; i < 32; ++i) { const int kk = 2 * i + (lane >> 5); scr[kk * 33 + (lane & 31)] = W[(size_t)(k0 + kk) * ldw + coff + n0 + (lane & 31)]; }
    LDS_WAIT(); asm volatile("" ::: "memory");
    const int c = lane & 7;
#pragma unroll
    for (int j = 0; j < 4; ++j) { const int n = (lane >> 3) + 8 * j; const LAS float* s = scr + (8 * c) * 33 + n;
        v4u o; o.x = pk2(s[0 * 33], s[1 * 33]); o.y = pk2(s[2 * 33], s[3 * 33]); o.z = pk2(s[4 * 33], s[5 * 33]); o.w = pk2(s[6 * 33], s[7 * 33]);
        *(GAS v4u*)(WT + (size_t)(row_off + n0 + n) * K + k0 + 8 * c) = o; }
    LDS_WAIT(); asm volatile("" ::: "memory");
}
#ifndef PROMASK
#define PROMASK 15
#endif
struct Ptrs {
    const float *x, *p; const int* pos;
    const float *a_w_in, *a_b_ig, *a_b_fg, *a_hg, *a_w_out, *kv_w, *kv_b, *b_w_q, *b_b_q, *b_sinks, *b_w_o, *b_b_o, *mix_g, *mix_b, *w_up, *w_dn, *mlp_g, *mlp_b, *w_gate, *b_gate, *w_proj;
    float* R; unsigned char* ws;
};
#define WSP(T, off) ((T*)(P.ws + (off)))

__device__ __forceinline__ void phase_prologue(const Ptrs& P, LAS unsigned char* lds, int gw, int NGW, int lane, int wave) {
    LAS float* scr = (LAS float*)(lds + wave * 16384);
    if (PROMASK & 1) {
        int base = 0;
#define WJOB(Wp, WTo, K_, N_, ldw_, roff_) do { const int items_ = ((K_) / 64) * ((N_) / 32); const int first_ = ((gw - base) % NGW + NGW) % NGW; \
        for (int r_ = first_; r_ < items_; r_ += NGW) p0_transpose_item((Wp), (K_), (N_), (ldw_), 0, WSP(bf16_t, WTo), (roff_), scr, r_, lane); base += items_; } while (0)
        WJOB(P.a_w_in, W_IN, 1024, 3072, LDW_IN, 0);
        WJOB(P.a_w_out, W_OUT, 1024, 1024, 1024, 0);
        WJOB(P.w_up, W_UP0, 1024, 4096, 4096, 0);
        WJOB(P.w_dn, W_DN0, 4096, 1024, 1024, 0);
        WJOB(P.w_gate, W_G0, 1024, 1024, 1024, 0);
        WJOB(P.w_proj, W_P0, 256, 1024, 1024, 0);
        WJOB(P.b_w_q, W_QKV, 1024, 1024, 1024, 0);
        WJOB(P.kv_w, W_QKV, 1024, 512, 512, 1024);
        WJOB(P.b_w_o, W_O, 1024, 1024, 1024, 0);
        WJOB(P.w_up + (size_t)D * FF, W_UP1, 1024, 4096, 4096, 0);
        WJOB(P.w_dn + (size_t)D * FF, W_DN1, 4096, 1024, 1024, 0);
        WJOB(P.w_gate + (size_t)D * D, W_G1, 1024, 1024, 1024, 0);
        WJOB(P.w_proj + (size_t)PLE * D, W_P1, 256, 1024, 1024, 0);
#undef WJOB
    }
    if (PROMASK & 2) {
        bf16_t* Xb = WSP(bf16_t, WS_XB); float* gates = WSP(float, WS_GATES);
        const float big = P.a_b_ig[lane & 3], bfg = P.a_b_fg[lane & 3];
        for (int m = gw; m < M; m += NGW) {
            const GAS f32x4* xr = (const GAS f32x4*)(P.x + (size_t)m * D) + lane;
            float s[8];
#pragma unroll
            for (int g = 0; g < 8; ++g) s[g] = 0.f;
            GAS unsigned long long* o8 = (GAS unsigned long long*)(Xb + (size_t)m * D) + lane;
#pragma unroll
            for (int j = 0; j < 4; ++j) {
                const f32x4 v = xr[64 * j];
                o8[64 * j] = (unsigned long long)pk2(v.x, v.y) | ((unsigned long long)pk2(v.z, v.w) << 32);
#pragma unroll
                for (int q = 0; q < 4; ++q) {
                    const int c = 256 * j + 4 * lane + q;
                    const f32x4 w0 = *(const f32x4*)(P.a_w_in + (size_t)c * LDW_IN + NIN), w1 = *(const f32x4*)(P.a_w_in + (size_t)c * LDW_IN + NIN + 4);
                    const float xv = v[q];
                    s[0] += xv * w0.x; s[1] += xv * w0.y; s[2] += xv * w0.z; s[3] += xv * w0.w;
                    s[4] += xv * w1.x; s[5] += xv * w1.y; s[6] += xv * w1.z; s[7] += xv * w1.w;
                }
            }
#pragma unroll
            for (int g = 0; g < 8; ++g) s[g] = wave_sum(s[g]);
            float z = s[0];
#pragma unroll
            for (int g = 1; g < 8; ++g) z = (lane == g) ? s[g] : z;
            if (lane < 8) {
                float r;
                if (lane < 4) r = GATE_CAP * tanhf((z + big) / GATE_CAP);
                else { const float c = GATE_CAP * tanhf((z + bfg) / GATE_CAP); r = fminf(c, 0.f) - log1pf(expf(-fabsf(c))); }
                gates[(size_t)m * 8 + lane] = r;
            }
        }
    }
    if (PROMASK & 4) {
        const GAS f32x4* pin = (const GAS f32x4*)P.p; GAS unsigned long long* po = (GAS unsigned long long*)WSP(bf16_t, WS_PB);
        const size_t n4 = (size_t)2 * M * PLE / 4;
        for (size_t i = (size_t)gw * 64 + lane; i < n4; i += (size_t)NGW * 64) { const f32x4 v = pin[i]; po[i] = (unsigned long long)pk2(v.x, v.y) | ((unsigned long long)pk2(v.z, v.w) << 32); }
    }
    if (PROMASK & 8) {
        float* cs = WSP(float, WS_CS);
        for (int i = gw * 64 + lane; i < M * 8; i += NGW * 64) {
            const int m = i >> 3, j = i & 7;
            const float inv_freq = (float)pow(500000.0, -(double)j * (2.0 / 16.0));
            const float ang = (float)P.pos[m] * inv_freq;
            cs[(size_t)m * 16 + j] = (float)cos((double)ang);
            cs[(size_t)m * 16 + 8 + j] = (float)sin((double)ang);
        }
        float* bq = WSP(float, WS_BQKV);
        for (int i = gw * 64 + lane; i < 1536; i += NGW * 64) bq[i] = (i < 1024) ? P.b_b_q[i] : P.kv_b[i - 1024];
    }
}

__device__ __forceinline__ void phase_mlstm_naive(const Ptrs& P, LAS unsigned char* lds, int bid, int G, int tid) {
    const bf16_t* qkvo = WSP(bf16_t, WS_QKVO); const float* gates = WSP(float, WS_GATES); float* hraw = P.R;
    LAS float* qs = (LAS float*)lds; LAS float* ks = qs + 128; LAS float* rn = ks + 128; LAS float* rd = rn + 512;
    const int kg = tid >> 5, vc = tid & 31;
    for (int item = bid; item < 256; item += G) {
        const int b = item >> 5, h = (item >> 3) & 3, vs = item & 7;
        float C[8], n[8];
#pragma unroll
        for (int i = 0; i < 8; ++i) { C[i] = 0.f; n[i] = 0.f; }
        float m = 0.f;
        for (int s = 0; s < S; ++s) {
            const size_t row = (size_t)b * S + s;
            const bf16_t* r = qkvo + row * NIN;
            if (tid < 128) qs[tid] = bf2f(r[h * 128 + tid]); else if (tid < 256) ks[tid - 128] = bf2f(r[512 + h * 128 + (tid - 128)]);
            const float v = bf2f(r[1024 + h * 256 + vs * 32 + vc]);
            const float li = gates[row * 8 + h], lf = gates[row * 8 + 4 + h];
            __syncthreads();
            const float mn = fmaxf(lf + m, li), fp = expf(lf + m - mn), ip = expf(li - mn);
            m = mn;
            float pn = 0.f, pd = 0.f;
#pragma unroll
            for (int i = 0; i < 8; ++i) {
                const int kk = kg * 8 + i; const float kv = ks[kk], qv = qs[kk];
                C[i] = fp * C[i] + ip * kv * v; n[i] = fp * n[i] + ip * kv;
                pn += C[i] * qv; pd += n[i] * qv;
            }
            rn[kg * 32 + vc] = pn; rd[kg * 32 + vc] = pd;
            __syncthreads();
            if (tid < 32) {
                float num = 0.f, den = 0.f;
#pragma unroll
                for (int g = 0; g < 16; ++g) { num += rn[g * 32 + tid]; den += rd[g * 32 + tid]; }
                hraw[row * D + h * 256 + vs * 32 + tid] = num / fmaxf(fabsf(den), expf(-m));
            }
        }
        __syncthreads();
    }
}
__device__ __forceinline__ void phase_headnorm(const Ptrs& P, int gw, int NGW, int lane) {
    const float* hraw = P.R; const bf16_t* qkvo = WSP(bf16_t, WS_QKVO); bf16_t* hb = WSP(bf16_t, WS_HB);
    for (int it = gw; it < M * MH; it += NGW) {
        const int m = it >> 2, h = it & 3;
        float v[4]; float s = 0.f;
#pragma unroll
        for (int j = 0; j < 4; ++j) { v[j] = hraw[(size_t)m * D + h * 256 + j * 64 + lane]; s += v[j]; }
        s = wave_sum(s);
        const float mu = s * (1.f / 256.f); float q = 0.f;
#pragma unroll
        for (int j = 0; j < 4; ++j) { v[j] -= mu; q += v[j] * v[j]; }
        q = wave_sum(q);
        const float rs = 1.f / sqrtf(q * (1.f / 256.f) + LN_EPS);
#pragma unroll
        for (int j = 0; j < 4; ++j) {
            const int c = h * 256 + j * 64 + lane;
            const float o = bf2f(qkvo[(size_t)m * NIN + 2048 + c]);
            hb[(size_t)m * D + c] = f2bf(sigmoidf_(o) * (v[j] * rs * P.a_hg[c]));
        }
    }
}
__device__ __forceinline__ void phase_ln(const Ptrs& P, const float* g, const float* bta, int gw, int NGW, int lane) {
    float* R = P.R; bf16_t* xb = WSP(bf16_t, WS_XB);
    f32x4 gv[4], bv[4];
#pragma unroll
    for (int j = 0; j < 4; ++j) { gv[j] = *(const f32x4*)(g + 256 * j + 4 * lane); bv[j] = *(const f32x4*)(bta + 256 * j + 4 * lane); }
    for (int m = gw; m < M; m += NGW) {
        GAS f32x4* xr = (GAS f32x4*)(R + (size_t)m * D) + lane;
        f32x4 v[4]; float s = 0.f;
#pragma unroll
        for (int j = 0; j < 4; ++j) { v[j] = xr[64 * j]; s += (v[j].x + v[j].y) + (v[j].z + v[j].w); }
        const float mean = wave_sum(s) * (1.f / D); float s2 = 0.f;
#pragma unroll
        for (int j = 0; j < 4; ++j) { v[j] = v[j] - mean; s2 += (v[j].x * v[j].x + v[j].y * v[j].y) + (v[j].z * v[j].z + v[j].w * v[j].w); }
        const float rstd = 1.f / sqrtf(wave_sum(s2) * (1.f / D) + LN_EPS);
        GAS unsigned long long* o8 = (GAS unsigned long long*)(xb + (size_t)m * D) + lane;
#pragma unroll
        for (int j = 0; j < 4; ++j) { const f32x4 o = v[j] * rstd * gv[j] + bv[j]; xr[64 * j] = o; o8[64 * j] = (unsigned long long)pk2(o.x, o.y) | ((unsigned long long)pk2(o.z, o.w) << 32); }
    }
}
__device__ __forceinline__ void phase_attn_naive(const Ptrs& P, LAS unsigned char* lds, int gw, int NGW, int lane, int wave) {
    const bf16_t* qkv = WSP(bf16_t, WS_QKV1); const float* cs = WSP(float, WS_CS); bf16_t* ob = WSP(bf16_t, WS_OB);
    LAS float* qsh = (LAS float*)lds + wave * 64;
    for (int it = gw; it < M * AH; it += NGW) {
        const int m = it >> 4, hq = it & 15, kvh = hq >> 2, b = m >> 12, s = m & (S - 1);
        float qv = bf2f(qkv[(size_t)m * NQKV + hq * 64 + lane]);
        {
            const float other = __shfl_xor(qv, 8);
            if (lane < 8) qv = qv * cs[(size_t)m * 16 + lane] - other * cs[(size_t)m * 16 + 8 + lane];
            else if (lane < 16) qv = qv * cs[(size_t)m * 16 + lane - 8] + other * cs[(size_t)m * 16 + 8 + lane - 8];
        }
        qsh[lane] = qv;
        LDS_WAIT(); __builtin_amdgcn_wave_barrier();
        float sc[2]; bool val[2];
#pragma unroll
        for (int r = 0; r < 2; ++r) {
            const int off = lane + 64 * r, j = s - off; val[r] = (j >= 0); sc[r] = -INFINITY;
            if (val[r]) {
                const size_t mk = (size_t)b * S + j; const bf16_t* kr = qkv + mk * NQKV + 1024 + kvh * 64;
                float kk[64];
#pragma unroll
                for (int d = 0; d < 64; ++d) kk[d] = bf2f(kr[d]);
                float acc = 0.f;
#pragma unroll
                for (int d = 0; d < 8; ++d) {
                    const float c = cs[mk * 16 + d], sn = cs[mk * 16 + 8 + d];
                    const float r1 = kk[d] * c - kk[d + 8] * sn, r2 = kk[d + 8] * c + kk[d] * sn;
                    acc += qsh[d] * r1 + qsh[d + 8] * r2;
                }
#pragma unroll
                for (int d = 16; d < 64; ++d) acc += qsh[d] * kk[d];
                sc[r] = acc;
            }
        }
        const float snk = P.b_sinks[hq];
        float mx = fmaxf(fmaxf(sc[0], sc[1]), snk);
#pragma unroll
        for (int o = 32; o > 0; o >>= 1) mx = fmaxf(mx, __shfl_xor(mx, o));
        float e0 = val[0] ? expf(sc[0] - mx) : 0.f, e1 = val[1] ? expf(sc[1] - mx) : 0.f;
        const float sum = wave_sum(e0 + e1);
        const float inv = 1.f / (sum + expf(snk - mx));
        e0 *= inv; e1 *= inv;
        float out = 0.f;
        const int nk = (s + 1 < WIN) ? s + 1 : WIN;
        for (int off = 0; off < nk; ++off) {
            const float p = (off < 64) ? __shfl(e0, off) : __shfl(e1, off - 64);
            const size_t mk = (size_t)b * S + (s - off);
            out += p * bf2f(qkv[mk * NQKV + 1280 + kvh * 64 + lane]);
        }
        ob[(size_t)m * D + hq * 64 + lane] = f2bf(out);
        LDS_WAIT(); __builtin_amdgcn_wave_barrier();
    }
}
constexpr int NWAVES = 8;
constexpr int RING_OFF = 0, RING_BYTES = 131072;
constexpr int LDSCTL_OFF = RING_BYTES, MISC_OFF = LDSCTL_OFF + 320;
constexpr int LDS_BYTES = 147456;
constexpr int CW_TMO = 0, CW_CODE = 1, CW_BAR = 4096;
constexpr size_t CTL_ZERO_BYTES = 1u << 20;
#ifndef MK_ONE_LAUNCH
#define MK_ONE_LAUNCH 1
#endif
constexpr int NPHASE = 18;

struct Args { const void* in[24]; float* out; unsigned char* ws; int ph_lo, ph_hi; };

__global__ void __launch_bounds__(NWAVES * 64, 2) mk_fwd(Args args) {
    extern __shared__ __attribute__((aligned(16))) unsigned char lds_raw[];
    LAS unsigned char* lds = (LAS unsigned char*)lds_raw;
    volatile LAS unsigned* MISC = (volatile LAS unsigned*)(lds + MISC_OFF);
    const int tid = threadIdx.x, lane = tid & 63, wave = __builtin_amdgcn_readfirstlane(tid >> 6);
    const int G = gridDim.x, bx = blockIdx.x;
    const int vcu = (G % 8 == 0) ? (bx % 8) * (G / 8) + bx / 8 : bx;
    const int gw = vcu * NWAVES + wave, NGW = G * NWAVES;
    Ptrs P;
    P.x = (const float*)args.in[0]; P.p = (const float*)args.in[1]; P.pos = (const int*)args.in[2];
    P.a_w_in = (const float*)args.in[3]; P.a_b_ig = (const float*)args.in[4]; P.a_b_fg = (const float*)args.in[5]; P.a_hg = (const float*)args.in[6]; P.a_w_out = (const float*)args.in[7];
    P.kv_w = (const float*)args.in[8]; P.kv_b = (const float*)args.in[9]; P.b_w_q = (const float*)args.in[10]; P.b_b_q = (const float*)args.in[11]; P.b_sinks = (const float*)args.in[12];
    P.b_w_o = (const float*)args.in[13]; P.b_b_o = (const float*)args.in[14]; P.mix_g = (const float*)args.in[15]; P.mix_b = (const float*)args.in[16];
    P.w_up = (const float*)args.in[17]; P.w_dn = (const float*)args.in[18]; P.mlp_g = (const float*)args.in[19]; P.mlp_b = (const float*)args.in[20];
    P.w_gate = (const float*)args.in[21]; P.b_gate = (const float*)args.in[22]; P.w_proj = (const float*)args.in[23];
    P.R = args.out; P.ws = args.ws;
    gu32* ctl = (gu32*)(P.ws + WS_CTL);
    for (int u = tid; u < (LDS_BYTES - LDSCTL_OFF) / 4; u += NWAVES * 64) ((LAS unsigned*)(lds + LDSCTL_OFF))[u] = 0u;
    __syncthreads();
    XcdBarrier bar; bar.bar = (unsigned*)(ctl + CW_BAR); bar.x = 0; bar.st = nullptr;
    if (MK_ONE_LAUNCH) bar = xcd_barrier_post((unsigned*)(ctl + CW_BAR), MISC + 8);
    const int lo = args.ph_lo, hi = args.ph_hi;
#define IN(k) (lo <= (k) && (k) < hi)
#define SEAM(k) do { if (IN(k) && IN((k) + 1)) xcd_barrier(bar); } while (0)
    bf16_t* Xb = WSP(bf16_t, WS_XB); bf16_t* U = WSP(bf16_t, WS_U); bf16_t* Pb = WSP(bf16_t, WS_PB); bf16_t* Hh = WSP(bf16_t, WS_HH);
    bf16_t* QKVO = WSP(bf16_t, WS_QKVO); bf16_t* HB = WSP(bf16_t, WS_HB); bf16_t* X3b = WSP(bf16_t, WS_X3B); bf16_t* QKV1 = WSP(bf16_t, WS_QKV1); bf16_t* OB = WSP(bf16_t, WS_OB);
#define GEMM(EpiT, E, Ap, Btp, N_, K_) do { pg8::Gemm g_{}; g_.A = (Ap); g_.Bt = (Btp); g_.M = M; g_.N = (N_); g_.K = (K_); pg8::StaticOrder S_; S_.init(M, (N_), G, bx); \
        pg8::gemm_phase<EpiT, pg8::StaticOrder, true, true>(lds + RING_OFF, g_, S_, (E)); } while (0)

    if (IN(0)) { phase_prologue(P, lds, gw, NGW, lane, wave); } SEAM(0);
    if (IN(1)) {
        { pg8::EpiBf16G<0> E{}; E.O = QKVO; E.ldc = NIN; E.nscale = 512; E.scale = 0.08838834764831845f; GEMM(pg8::EpiBf16G<0>, E, Xb, WSP(bf16_t, W_IN), NIN, D); }
        { pg8::EpiBf16G<0> E{}; E.O = U; E.ldc = D; E.nscale = 0; E.scale = 1.f; GEMM(pg8::EpiBf16G<0>, E, Pb, WSP(bf16_t, W_P0), D, PLE); }
    } SEAM(1);
    if (IN(2)) { phase_mlstm_naive(P, lds, vcu, G, tid); } SEAM(2);
    if (IN(3)) { phase_headnorm(P, gw, NGW, lane); } SEAM(3);
    if (IN(4)) { pg8::EpiRes E{}; E.base = P.x; E.R = P.R; E.alpha = ALPHA; GEMM(pg8::EpiRes, E, HB, WSP(bf16_t, W_OUT), D, D); } SEAM(4);
    if (IN(5)) { phase_ln(P, P.mix_g, P.mix_b, gw, NGW, lane); } SEAM(5);
    if (IN(6)) { pg8::EpiBf16G<1> E{}; E.O = Hh; E.ldc = FF; E.nscale = 0; E.scale = 1.f; GEMM(pg8::EpiBf16G<1>, E, Xb, WSP(bf16_t, W_UP0), FF, D); } SEAM(6);
    if (IN(7)) { pg8::EpiRes E{}; E.base = P.R; E.R = P.R; E.alpha = ALPHA; GEMM(pg8::EpiRes, E, Hh, WSP(bf16_t, W_DN0), D, FF); } SEAM(7);
    if (IN(8)) { phase_ln(P, P.mlp_g, P.mlp_b, gw, NGW, lane); } SEAM(8);
    if (IN(9)) { pg8::EpiPle E{}; E.R = P.R; E.bias = P.b_gate; E.U = U; E.Xb = X3b; GEMM(pg8::EpiPle, E, Xb, WSP(bf16_t, W_G0), D, D); } SEAM(9);
    if (IN(10)) {
        { pg8::EpiBf16G<0> E{}; E.O = QKV1; E.bias = WSP(float, WS_BQKV); E.ldc = NQKV; E.nscale = 1024; E.scale = 0.125f; GEMM(pg8::EpiBf16G<0>, E, X3b, WSP(bf16_t, W_QKV), NQKV, D); }
        { pg8::EpiBf16G<0> E{}; E.O = U; E.ldc = D; E.nscale = 0; E.scale = 1.f; GEMM(pg8::EpiBf16G<0>, E, Pb + (size_t)M * PLE, WSP(bf16_t, W_P1), D, PLE); }
    } SEAM(10);
    if (IN(11)) { phase_attn_naive(P, lds, gw, NGW, lane, wave); } SEAM(11);
    if (IN(12)) { pg8::EpiRes E{}; E.base = P.R; E.R = P.R; E.alpha = ALPHA; E.bias = P.b_b_o; GEMM(pg8::EpiRes, E, OB, WSP(bf16_t, W_O), D, D); } SEAM(12);
    if (IN(13)) { phase_ln(P, P.mix_g + D, P.mix_b + D, gw, NGW, lane); } SEAM(13);
    if (IN(14)) { pg8::EpiBf16G<1> E{}; E.O = Hh; E.ldc = FF; E.nscale = 0; E.scale = 1.f; GEMM(pg8::EpiBf16G<1>, E, Xb, WSP(bf16_t, W_UP1), FF, D); } SEAM(14);
    if (IN(15)) { pg8::EpiRes E{}; E.base = P.R; E.R = P.R; E.alpha = ALPHA; GEMM(pg8::EpiRes, E, Hh, WSP(bf16_t, W_DN1), D, FF); } SEAM(15);
    if (IN(16)) { phase_ln(P, P.mlp_g + D, P.mlp_b + D, gw, NGW, lane); } SEAM(16);
    if (IN(17)) { pg8::EpiPle E{}; E.R = P.R; E.bias = P.b_gate + D; E.U = U; E.Xb = nullptr; GEMM(pg8::EpiPle, E, Xb, WSP(bf16_t, W_G1), D, D); }
#undef IN
#undef SEAM
#undef GEMM
}

extern "C" void kernel_launch(void* const* d_in, const int* in_sizes, int n_in, void* d_out, int out_size, void* d_ws, size_t ws_size, hipStream_t stream) {
    static int grid = 0;
    if (grid == 0) {
        if (n_in != 24 || in_sizes[0] != M * D || out_size != M * D || ws_size < WS_END) {
            fprintf(stderr, "kernel_launch: unexpected shapes: n_in %d in0 %d out %d ws %zu; nothing launched\n", n_in, n_in > 0 ? in_sizes[0] : -1, out_size, ws_size); grid = -1; return; }
        int dev = 0, cus = 0, per_cu = 0;
        if (hipGetDevice(&dev) != hipSuccess || hipDeviceGetAttribute(&cus, hipDeviceAttributeMultiprocessorCount, dev) != hipSuccess) { fprintf(stderr, "kernel_launch: device query failed\n"); grid = -1; return; }
        if (hipFuncSetAttribute((const void*)mk_fwd, hipFuncAttributeMaxDynamicSharedMemorySize, LDS_BYTES) != hipSuccess) { fprintf(stderr, "kernel_launch: hipFuncSetAttribute failed\n"); grid = -1; return; }
        if (hipOccupancyMaxActiveBlocksPerMultiprocessor(&per_cu, (const void*)mk_fwd, NWAVES * 64, LDS_BYTES) != hipSuccess || per_cu < 1)
            fprintf(stderr, "kernel_launch: note: occupancy query reports %d workgroups per CU\n", per_cu);
        (void)hipGetLastError();
        grid = cus;
    }
    if (grid < 0) return;
    if (hipMemsetAsync((char*)d_ws + WS_CTL, 0, CTL_ZERO_BYTES, stream) != hipSuccess) { fprintf(stderr, "kernel_launch: memset failed\n"); return; }
    Args a{};
    for (int i = 0; i < 24; ++i) a.in[i] = d_in[i];
    a.out = (float*)d_out; a.ws = (unsigned char*)d_ws;
#if MK_ONE_LAUNCH
    a.ph_lo = 0; a.ph_hi = NPHASE;
    hipLaunchKernelGGL(mk_fwd, dim3(grid), dim3(NWAVES * 64), LDS_BYTES, stream, a);
#else
    for (int ph = 0; ph < NPHASE; ++ph) { a.ph_lo = ph; a.ph_hi = ph + 1; hipLaunchKernelGGL(mk_fwd, dim3(grid), dim3(NWAVES * 64), LDS_BYTES, stream, a); }
#endif
    const hipError_t le = hipPeekAtLastError();
    if (le != hipSuccess) fprintf(stderr, "kernel_launch: launch failed: %s\n", hipGetErrorName(le));
}
```

```cpp
#include <hip/hip_runtime.h>
#include <cstdio>
#include <cstdint>

typedef unsigned short bf16_t;
typedef float f32x4 __attribute__((ext_vector_type(4)));

namespace cfg {
constexpr int D = 1024, NB = 8, S = 4096, M = NB * S;
constexpr int MH = 4, MDV = 256, MDK = 128, NIN = 3072, LDW_IN = 3080;
constexpr int AH = 16, AKV = 4, AHD = 64, WIN = 128, NQKV = 1536;
constexpr int FF = 4096, PLE = 256;
constexpr float LN_EPS = 1e-5f;
constexpr float ALPHA = 1.41421356237309515f;
constexpr float GATE_CAP = 15.0f;
constexpr size_t MiB = 1u << 20;
constexpr size_t WS_CTL = 0;
constexpr size_t WS_GATES = 1 * MiB;
constexpr size_t WS_CS = 2 * MiB;
constexpr size_t WS_BQKV = 56 * MiB;
constexpr size_t WS_W = 4 * MiB;
constexpr size_t W_IN = WS_W;
constexpr size_t W_OUT = W_IN + 6 * MiB;
constexpr size_t W_UP0 = W_OUT + 2 * MiB;
constexpr size_t W_DN0 = W_UP0 + 8 * MiB;
constexpr size_t W_G0 = W_DN0 + 8 * MiB;
constexpr size_t W_P0 = W_G0 + 2 * MiB;
constexpr size_t W_QKV = W_P0 + MiB / 2;
constexpr size_t W_O = W_QKV + 3 * MiB;
constexpr size_t W_UP1 = W_O + 2 * MiB;
constexpr size_t W_DN1 = W_UP1 + 8 * MiB;
constexpr size_t W_G1 = W_DN1 + 8 * MiB;
constexpr size_t W_P1 = W_G1 + 2 * MiB;
constexpr size_t WS_XB = 64 * MiB;
constexpr size_t WS_U = 128 * MiB;
constexpr size_t WS_PB = 192 * MiB;
constexpr size_t WS_ST = 224 * MiB;
constexpr size_t WS_HH = 256 * MiB;
constexpr size_t WS_QKVO = WS_HH;
constexpr size_t WS_HB = WS_HH + 192 * MiB;
constexpr size_t WS_X3B = WS_HH;
constexpr size_t WS_QKV1 = WS_HH + 64 * MiB;
constexpr size_t WS_OB = WS_HH + 192 * MiB;
constexpr size_t WS_END = 512 * MiB;
}
using namespace cfg;

__device__ __forceinline__ float bf2f(bf16_t v) { return __uint_as_float((unsigned)v << 16); }
__device__ __forceinline__ bf16_t f2bf(float f) { unsigned u = __float_as_uint(f); return (bf16_t)((u + 0x7fffu + ((u >> 16) & 1u)) >> 16); }
__device__ __forceinline__ float sigmoidf_(float z) { return 1.f / (1.f + expf(-z)); }

namespace pg8 {
#define PG8_LAS __attribute__((address_space(3)))
typedef unsigned short bf16_t;
typedef short bf16x8 __attribute__((ext_vector_type(8)));
typedef float f32x4 __attribute__((ext_vector_type(4)));
typedef unsigned u32x4 __attribute__((ext_vector_type(4)));
constexpr int BM = 256, BK = 64, HALF = 128, HTB = HALF * BK * 2  , STAGE_BYTES = 8 * HTB, NXCD = 8, WGM = 8;

__host__ __device__ __forceinline__ int lds_byte(int r, int c) { const int st = (r >> 4) * 2 + (c >> 5), rr = r & 15, cc = c & 31, ob = rr * 64 + cc * 2; return st * 1024 + (ob ^ (((ob >> 9) & 1) << 5)); }
__host__ __device__ __forceinline__ void stage_rc(int b, int& R, int& C) { const int st = b / 1024, sb = b % 1024, swz = sb ^ (((sb >> 9) & 1) << 5); R = (st >> 1) * 16 + swz / 64; C = (st & 1) * 32 + (swz % 64) / 2; }
__host__ __device__ __forceinline__ int perm32(int rho) { const int n = rho >> 4, i = rho & 15; return 8 * (i >> 2) + 4 * n + (i & 3); }

struct Unit { int pm, pn; };
struct Gemm { const bf16_t* A; const bf16_t* Bt; int M, N, K, pad; };

struct StaticOrder {
    int nM, nN, nwg, G, c;
    __host__ __device__ void init(int M, int N, int G_, int c_) { nM = M / BM; nN = N / BM; nwg = nM * nN; G = G_; c = c_; }
    __host__ __device__ bool next(int i, Unit& u) const {
        const long L = (long)i * G + c; if (L >= nwg) return false;
        int wgid = (int)L; { const int q = nwg / NXCD, r = nwg % NXCD, xcd = wgid % NXCD, off = wgid / NXCD; wgid = (xcd < r ? xcd * (q + 1) : r * (q + 1) + (xcd - r) * q) + off; }
        const int nig = WGM * nN, gid = wgid / nig, fm = gid * WGM, gsz = (nM - fm) < WGM ? (nM - fm) : WGM;
        u.pm = fm + ((wgid % nig) % gsz); u.pn = (wgid % nig) / gsz; return true;
    }
    __device__ __forceinline__ void a_ready(const Unit&) const {}
    __device__ __forceinline__ void done(const Unit&) const {}
};

template <class Epi, class Sched, bool ALIGN_EPI = false, bool SP2 = false>
__device__ __forceinline__ void gemm_phase(PG8_LAS unsigned char* lds, const Gemm g, const Sched& S, const Epi& E) {
    int tid_ = threadIdx.x; asm volatile("" : "+v"(tid_));
    const int tid = tid_, wid = __builtin_amdgcn_readfirstlane(tid >> 6), lane = tid & 63, wr = wid >> 2, wc = wid & 3, fr = lane & 15, fq = lane >> 4;
    const int K = g.K, nt = K / BK;
    unsigned voffA[2], voffB[2];
#pragma unroll
    for (int i = 0; i < 2; ++i) { int R, C; stage_rc(tid * 16 + i * 8192, R, C); const int Rb = Epi::PERM ? ((R & ~31) + perm32(R & 31)) : R;
        voffA[i] = (unsigned)(R * K + C) * 2u; voffB[i] = (unsigned)(Rb * K + C) * 2u; }
    const size_t kstep = (size_t)(BK * 2);
    const size_t hstep = (size_t)HALF * K * 2;
    const size_t tstep = 2 * hstep;
    const unsigned ldsw = (unsigned)wid * 1024u;
    const int aoff = lds_byte(wr * 64 + fr, fq * 8), boff = lds_byte(wc * 32 + fr, fq * 8);
#define PG8_SA(b, h) (((b) * 2 + (h)) * HTB)
#define PG8_SB(b, h) ((4 + (b) * 2 + (h)) * HTB)
#define PG8_STAGE(bufoff, gbase, voff) do { _Pragma("unroll") for (int _i = 0; _i < 2; ++_i) \
        __builtin_amdgcn_global_load_lds((const unsigned*)((const char*)(gbase) + (voff)[_i]), (PG8_LAS unsigned*)(lds + (bufoff) + ldsw + _i * 8192), 16, 0, 0); } while (0)
#define PG8_LDA(dst, b, h) do { _Pragma("unroll") for (int m = 0; m < 4; ++m) _Pragma("unroll") for (int k = 0; k < 2; ++k) dst[m][k] = *(const PG8_LAS bf16x8*)(lds + PG8_SA(b, h) + aoff + m * 2048 + k * 1024); } while (0)
#define PG8_LDB(dst, b, h) do { _Pragma("unroll") for (int n = 0; n < 2; ++n) _Pragma("unroll") for (int k = 0; k < 2; ++k) dst[n][k] = *(const PG8_LAS bf16x8*)(lds + PG8_SB(b, h) + boff + n * 2048 + k * 1024); } while (0)
#define PG8_MMA(ai, bj, At, Bt) do { __builtin_amdgcn_s_setprio(1); _Pragma("unroll") for (int m = 0; m < 4; ++m) _Pragma("unroll") for (int n = 0; n < 2; ++n) _Pragma("unroll") for (int k = 0; k < 2; ++k) \
        acc[ai][bj][m][n] = __builtin_amdgcn_mfma_f32_16x16x32_bf16(Bt[n][k], At[m][k], acc[ai][bj][m][n], 0, 0, 0); __builtin_amdgcn_s_setprio(0); } while (0)
#define PG8_WAIT_V(n) asm volatile("s_waitcnt vmcnt(" #n ")" ::: "memory")
#define PG8_WAIT_L(n) asm volatile("s_waitcnt lgkmcnt(" #n ")" ::: "memory")
#define PG8_BAR __builtin_amdgcn_s_barrier()
#define PG8_SCHED __builtin_amdgcn_sched_barrier(0)
    Unit cur, nxt; int ui = 0;
    if (!S.next(0, cur)) return;
    f32x4 acc[2][2][4][2];
#pragma unroll
    for (int a = 0; a < 2; ++a)
#pragma unroll
        for (int b = 0; b < 2; ++b)
#pragma unroll
            for (int m = 0; m < 4; ++m)
#pragma unroll
                for (int n = 0; n < 2; ++n) acc[a][b][m][n] = (f32x4){0.f, 0.f, 0.f, 0.f};
    bf16x8 At[4][2], B0[2][2], B1[2][2];
    const char* cA = (const char*)g.A + (size_t)cur.pm * tstep; const char* cB = (const char*)g.Bt + (size_t)cur.pn * tstep;
    S.a_ready(cur);
    if constexpr (SP2) {
        PG8_STAGE(PG8_SB(0, 0), cB, voffB); PG8_STAGE(PG8_SB(0, 1), cB + hstep, voffB); PG8_STAGE(PG8_SA(0, 0), cA, voffA); PG8_STAGE(PG8_SA(0, 1), cA + hstep, voffA);
        if (wr == 1) PG8_BAR;
        PG8_WAIT_V(2); PG8_BAR;
        PG8_STAGE(PG8_SB(1, 0), cB + kstep, voffB); PG8_STAGE(PG8_SA(1, 0), cA + kstep, voffA); PG8_STAGE(PG8_SB(1, 1), cB + hstep + kstep, voffB);
        PG8_WAIT_V(6); PG8_BAR;
    } else {
        PG8_STAGE(PG8_SB(0, 0), cB, voffB); PG8_STAGE(PG8_SA(0, 0), cA, voffA); PG8_STAGE(PG8_SB(0, 1), cB + hstep, voffB); PG8_STAGE(PG8_SA(0, 1), cA + hstep, voffA);
        if (wr == 1) PG8_BAR;
        PG8_WAIT_V(4); PG8_BAR;
        PG8_STAGE(PG8_SB(1, 0), cB + kstep, voffB); PG8_STAGE(PG8_SA(1, 0), cA + kstep, voffA); PG8_STAGE(PG8_SB(1, 1), cB + hstep + kstep, voffB);
        PG8_WAIT_V(6); PG8_BAR;
    }
    for (;;) {
        const bool has_next = S.next(ui + 1, nxt);
        const char* nA = has_next ? (const char*)g.A + (size_t)nxt.pm * tstep : cA; const char* nB = has_next ? (const char*)g.Bt + (size_t)nxt.pn * tstep : cB;
        for (int t = 0; t < nt; t += 2) {
            const bool last = (t == nt - 2);
            const char* a1 = cA + (size_t)(t + 1) * kstep;
            const char* a2 = last ? nA : cA + (size_t)(t + 2) * kstep; const char* b2 = last ? nB : cB + (size_t)(t + 2) * kstep;
            const char* a3 = a2 + kstep; const char* b3 = b2 + kstep;
            if (last && has_next) S.a_ready(nxt);
            if constexpr (SP2) {
            PG8_LDB(B0, 0, 0); PG8_LDB(B1, 0, 1); PG8_SCHED; PG8_LDA(At, 0, 0); PG8_STAGE(PG8_SA(1, 1), a1 + hstep, voffA);
            PG8_WAIT_V(8); PG8_WAIT_L(0); PG8_BAR; PG8_MMA(0, 0, At, B0); PG8_MMA(0, 1, At, B1); PG8_BAR; PG8_SCHED;
            PG8_LDA(At, 0, 1); PG8_STAGE(PG8_SB(0, 0), b2, voffB); PG8_STAGE(PG8_SB(0, 1), b2 + hstep, voffB); PG8_STAGE(PG8_SA(0, 0), a2, voffA);
            PG8_WAIT_V(8); PG8_WAIT_L(0); PG8_BAR; PG8_MMA(1, 0, At, B0); PG8_MMA(1, 1, At, B1); PG8_BAR; PG8_SCHED;
            PG8_LDB(B0, 1, 0); PG8_LDB(B1, 1, 1); PG8_SCHED; PG8_LDA(At, 1, 0); PG8_STAGE(PG8_SA(0, 1), a2 + hstep, voffA);
            PG8_WAIT_V(8); PG8_WAIT_L(0); PG8_BAR; PG8_MMA(0, 0, At, B0); PG8_MMA(0, 1, At, B1); PG8_BAR; PG8_SCHED;
            PG8_LDA(At, 1, 1); PG8_STAGE(PG8_SB(1, 0), b3, voffB); PG8_STAGE(PG8_SB(1, 1), b3 + hstep, voffB); PG8_STAGE(PG8_SA(1, 0), a3, voffA);
            PG8_WAIT_V(8); PG8_WAIT_L(0); PG8_BAR; PG8_MMA(1, 0, At, B0); PG8_MMA(1, 1, At, B1); PG8_BAR; PG8_SCHED;
            } else {
            PG8_LDB(B0, 0, 0); PG8_SCHED; PG8_LDA(At, 0, 0); PG8_STAGE(PG8_SA(1, 1), a1 + hstep, voffA);
            PG8_WAIT_L(8); PG8_BAR; PG8_WAIT_L(0); PG8_MMA(0, 0, At, B0); PG8_BAR; PG8_SCHED;
            PG8_LDB(B1, 0, 1); PG8_STAGE(PG8_SB(0, 0), b2, voffB);
            PG8_BAR; PG8_WAIT_L(0); PG8_MMA(0, 1, At, B1); PG8_BAR;
            PG8_LDA(At, 0, 1); PG8_STAGE(PG8_SA(0, 0), a2, voffA);
            PG8_BAR; PG8_WAIT_L(0); PG8_MMA(1, 0, At, B0); PG8_BAR; PG8_SCHED;
            PG8_STAGE(PG8_SB(0, 1), b2 + hstep, voffB);
            PG8_WAIT_V(6); PG8_BAR; PG8_MMA(1, 1, At, B1); PG8_BAR;
            PG8_LDB(B0, 1, 0); PG8_SCHED; PG8_LDA(At, 1, 0); PG8_STAGE(PG8_SA(0, 1), a2 + hstep, voffA);
            PG8_WAIT_L(8); PG8_BAR; PG8_WAIT_L(0); PG8_MMA(0, 0, At, B0); PG8_BAR; PG8_SCHED;
            PG8_LDB(B1, 1, 1); PG8_STAGE(PG8_SB(1, 0), b3, voffB);
            PG8_BAR; PG8_WAIT_L(0); PG8_MMA(0, 1, At, B1); PG8_BAR;
            PG8_LDA(At, 1, 1); PG8_STAGE(PG8_SA(1, 0), a3, voffA);
            PG8_BAR; PG8_WAIT_L(0); PG8_MMA(1, 0, At, B0); PG8_BAR; PG8_SCHED;
            PG8_STAGE(PG8_SB(1, 1), b3 + hstep, voffB);
            PG8_WAIT_V(6); PG8_BAR; PG8_MMA(1, 1, At, B1); PG8_BAR;
            }
        }
        if constexpr (ALIGN_EPI) { if (wr == 0) PG8_BAR; }
        if constexpr (!Epi::AFTER_DRAIN) { E(acc, cur, wr, wc, fr, fq); S.done(cur); }
        if (!has_next) break;
#pragma unroll
        for (int a = 0; a < 2; ++a)
#pragma unroll
            for (int b = 0; b < 2; ++b)
#pragma unroll
                for (int m = 0; m < 4; ++m)
#pragma unroll
                    for (int n = 0; n < 2; ++n) acc[a][b][m][n] = (f32x4){0.f, 0.f, 0.f, 0.f};
        cur = nxt; cA = nA; cB = nB; ++ui;
        if constexpr (ALIGN_EPI) { if (wr == 1) PG8_BAR; }
    }
    PG8_WAIT_V(0);
    if constexpr (!ALIGN_EPI) { if (wr == 0) PG8_BAR; }
    PG8_BAR;
    if constexpr (Epi::AFTER_DRAIN) { E.fused(acc, cur, wr, wc, fr, fq, lds, wid, lane); S.done(cur); }
#undef PG8_SA
#undef PG8_SB
#undef PG8_STAGE
#undef PG8_LDA
#undef PG8_LDB
#undef PG8_MMA
#undef PG8_WAIT_V
#undef PG8_WAIT_L
#undef PG8_BAR
#undef PG8_SCHED
}
}
namespace pg8 {
typedef float f32x2 __attribute__((ext_vector_type(2)));
typedef unsigned u32x2 __attribute__((ext_vector_type(2)));
typedef __bf16 bf16x2_t __attribute__((ext_vector_type(2)));
__device__ __forceinline__ unsigned cvtpk(float lo, float hi) { f32x2 v = {lo, hi}; bf16x2_t b = __builtin_convertvector(v, bf16x2_t); return __builtin_bit_cast(unsigned, b); }
__device__ __forceinline__ float fast_sigmoid(float z) { return __builtin_amdgcn_rcpf(1.0f + __builtin_amdgcn_exp2f(-1.4426950408889634f * z)); }
template <int ACT> struct EpiBf16G {
    static constexpr bool PERM = true, AFTER_DRAIN = false;
    bf16_t* O; const float* bias; int ldc, nscale; float scale; int pad;
    __device__ __forceinline__ void operator()(const f32x4 (&acc)[2][2][4][2], const Unit& u, int wr, int wc, int fr, int fq) const {
        const int row0 = u.pm * BM + wr * 64 + fr, col0 = u.pn * BM + wc * 32 + 8 * fq;
        f32x4 bv[2][2]; float sc[2];
#pragma unroll
        for (int bj = 0; bj < 2; ++bj) { sc[bj] = (col0 + bj * HALF < nscale) ? scale : 1.f;
#pragma unroll
            for (int n = 0; n < 2; ++n) bv[bj][n] = bias ? *(const f32x4*)(bias + col0 + bj * HALF + 4 * n) : (f32x4){0.f, 0.f, 0.f, 0.f}; }
#pragma unroll
        for (int ai = 0; ai < 2; ++ai)
#pragma unroll
            for (int m = 0; m < 4; ++m) { bf16_t* rowp = O + (size_t)(row0 + ai * HALF + m * 16) * ldc + col0;
#pragma unroll
                for (int bj = 0; bj < 2; ++bj) { f32x4 v0 = acc[ai][bj][m][0] + bv[bj][0], v1 = acc[ai][bj][m][1] + bv[bj][1];
                    if (ACT == 1) { v0 = __builtin_elementwise_max(v0, (f32x4){0.f, 0.f, 0.f, 0.f}); v1 = __builtin_elementwise_max(v1, (f32x4){0.f, 0.f, 0.f, 0.f}); v0 = v0 * v0; v1 = v1 * v1; }
                    v0 = v0 * sc[bj]; v1 = v1 * sc[bj];
                    u32x4 w; w.x = cvtpk(v0[0], v0[1]); w.y = cvtpk(v0[2], v0[3]); w.z = cvtpk(v1[0], v1[1]); w.w = cvtpk(v1[2], v1[3]);
                    *(u32x4*)(rowp + bj * HALF) = w; } }
    }
};
struct EpiRes {
    static constexpr bool PERM = false, AFTER_DRAIN = false;
    const float* base; float* R; const float* bias; float alpha; int pad;
    __device__ __forceinline__ void operator()(const f32x4 (&acc)[2][2][4][2], const Unit& u, int wr, int wc, int fr, int fq) const {
        const int col0 = u.pn * BM + wc * 32 + 4 * fq;
        f32x4 bv[2][2];
#pragma unroll
        for (int bj = 0; bj < 2; ++bj)
#pragma unroll
            for (int n = 0; n < 2; ++n) bv[bj][n] = bias ? *(const f32x4*)(bias + col0 + bj * HALF + n * 16) : (f32x4){0.f, 0.f, 0.f, 0.f};
#pragma unroll
        for (int ai = 0; ai < 2; ++ai)
#pragma unroll
            for (int m = 0; m < 4; ++m) { const size_t off = (size_t)(u.pm * BM + ai * HALF + wr * 64 + m * 16 + fr) * 1024 + col0;
#pragma unroll
                for (int bj = 0; bj < 2; ++bj)
#pragma unroll
                    for (int n = 0; n < 2; ++n) { const size_t idx = off + bj * HALF + n * 16; const f32x4 b = *(const f32x4*)(base + idx);
                        *(f32x4*)(R + idx) = b * alpha + acc[ai][bj][m][n] + bv[bj][n]; }
                if (m & 1) asm volatile("" ::: "memory"); }
    }
};
struct EpiPle {
    static constexpr bool PERM = false, AFTER_DRAIN = false;
    float* R; const float* bias; const bf16_t* U; bf16_t* Xb;
    __device__ __forceinline__ void operator()(const f32x4 (&acc)[2][2][4][2], const Unit& u, int wr, int wc, int fr, int fq) const {
        const int col0 = u.pn * BM + wc * 32 + 4 * fq;
        f32x4 bv[2][2];
#pragma unroll
        for (int bj = 0; bj < 2; ++bj)
#pragma unroll
            for (int n = 0; n < 2; ++n) bv[bj][n] = *(const f32x4*)(bias + col0 + bj * HALF + n * 16);
#pragma unroll
        for (int ai = 0; ai < 2; ++ai)
#pragma unroll
            for (int m = 0; m < 4; ++m) { const size_t off = (size_t)(u.pm * BM + ai * HALF + wr * 64 + m * 16 + fr) * 1024 + col0;
#pragma unroll
                for (int bj = 0; bj < 2; ++bj)
#pragma unroll
                    for (int n = 0; n < 2; ++n) { const size_t idx = off + bj * HALF + n * 16; const f32x4 r0 = *(const f32x4*)(R + idx); const u32x2 uw = *(const u32x2*)(U + idx);
                        const f32x4 z = acc[ai][bj][m][n] + bv[bj][n];
                        f32x4 uv; uv[0] = __uint_as_float(uw.x << 16); uv[1] = __uint_as_float(uw.x & 0xffff0000u); uv[2] = __uint_as_float(uw.y << 16); uv[3] = __uint_as_float(uw.y & 0xffff0000u);
                        f32x4 r; r[0] = r0[0] + fast_sigmoid(z[0]) * uv[0]; r[1] = r0[1] + fast_sigmoid(z[1]) * uv[1]; r[2] = r0[2] + fast_sigmoid(z[2]) * uv[2]; r[3] = r0[3] + fast_sigmoid(z[3]) * uv[3];
                        *(f32x4*)(R + idx) = r;
                        if (Xb) { u32x2 w; w.x = cvtpk(r[0], r[1]); w.y = cvtpk(r[2], r[3]); *(u32x2*)(Xb + idx) = w; } }
                if (m & 1) asm volatile("" ::: "memory"); }
    }
};
}

#define GAS __attribute__((address_space(1)))
#define LAS __attribute__((address_space(3)))

typedef unsigned v4u __attribute__((ext_vector_type(4)));


typedef GAS unsigned gu32;
typedef GAS unsigned long long gu64;
#define RLX_AGENT __ATOMIC_RELAXED, __HIP_MEMORY_SCOPE_AGENT
#define LDS_WAIT() asm volatile("s_waitcnt lgkmcnt(0)" ::: "memory")
#define VM_WAIT() asm volatile("s_waitcnt vmcnt(0)" ::: "memory")
__device__ __forceinline__ unsigned long long rt() { return __builtin_amdgcn_s_memrealtime(); }

#define XB_TMO      128
#define XB_XCNT(j)  (256  + 64 * (j))
#define XB_XSUB(j)  (1280 + 64 * (j))
#define XB_XGEN(j)  (2304 + 64 * (j))
#define XB_TOP      3328
#define XB_TOPGEN   3392
#define XCD_BAR_WORDS 3456
#define XB_SPIN_CAP (1u << 18)

__device__ __forceinline__ unsigned xb_ld(unsigned* p)              { return __hip_atomic_load(p, __ATOMIC_RELAXED, __HIP_MEMORY_SCOPE_AGENT); }
__device__ __forceinline__ unsigned xb_add(unsigned* p, unsigned v) { return __hip_atomic_fetch_add(p, v, __ATOMIC_RELAXED, __HIP_MEMORY_SCOPE_AGENT); }
__device__ __forceinline__ unsigned xb_xcc_id() { return (unsigned)__builtin_amdgcn_s_getreg((3 << 11) | 20) & 0xFu; }
#define XB_SPIN(cond, bar) do { unsigned _sp = 0; while (cond) { __builtin_amdgcn_s_sleep(1); \
    if ((++_sp & 255u) == 0u) { if (xb_ld(&(bar)[XB_TMO])) break; if (_sp > XB_SPIN_CAP) { atomicAdd(&(bar)[XB_TMO], 1u); break; } } } } while (0)

struct XcdBarrier {
    unsigned* bar; unsigned x;
    volatile LAS unsigned* st;
};

__device__ __forceinline__ XcdBarrier xcd_barrier_post(unsigned* bar, volatile LAS unsigned* st) {
    XcdBarrier b; b.bar = bar; b.x = xb_xcc_id(); b.st = st;
    if (threadIdx.x == 0) (void)xb_add(&bar[XB_XCNT(b.x)], 1u);
    return b;
}
__device__ __forceinline__ void xcd_barrier_complete(unsigned* bar, unsigned x, unsigned& nloc, unsigned& nx) {
    const unsigned G = gridDim.x * gridDim.y * gridDim.z;
    unsigned sum, cnt, mine, sp = 0u;
    for (;;) {
        sum = 0u; cnt = 0u; mine = 0u;
#pragma unroll
        for (unsigned j = 0; j < 16; ++j) { const unsigned c = xb_ld(&bar[XB_XCNT(j)]); sum += c; cnt += (c > 0u) ? 1u : 0u; mine = (j == x) ? c : mine; }
        if (sum == G) break;
        __builtin_amdgcn_s_sleep(1);
        if ((++sp & 255u) == 0u) { if (xb_ld(&bar[XB_TMO])) break; if (sp > XB_SPIN_CAP) { atomicAdd(&bar[XB_TMO], 1u); break; } }
    }
    nloc = mine > 0u ? mine : 1u; nx = cnt > 0u ? cnt : 1u;
}

__device__ __forceinline__ void xcd_barrier(const XcdBarrier& b) {
    asm volatile("s_waitcnt vmcnt(0)" ::: "memory");
    __syncthreads();
    if (threadIdx.x == 0) {
        unsigned* bar = b.bar;
        __builtin_amdgcn_s_waitcnt(0);
        unsigned nloc = b.st[0], nx = b.st[1];
        if (nloc == 0u) { xcd_barrier_complete(bar, b.x, nloc, nx); b.st[0] = nloc; b.st[1] = nx; }
        const unsigned old = xb_add(&bar[XB_XSUB(b.x)], 1u);
        const unsigned gen = old / nloc;
        if (old + 1u == (gen + 1u) * nloc) {
            __builtin_amdgcn_fence(__ATOMIC_RELEASE, "agent");
            asm volatile("s_waitcnt vmcnt(0)" ::: "memory");
            const unsigned og = xb_add(&bar[XB_TOP], 1u);
            const unsigned tg = og / nx;
            if (og + 1u == (tg + 1u) * nx) xb_add(&bar[XB_TOPGEN], 1u);
            else XB_SPIN(xb_ld(&bar[XB_TOPGEN]) == tg, bar);
            __builtin_amdgcn_fence(__ATOMIC_ACQUIRE, "agent");
            xb_add(&bar[XB_XGEN(b.x)], 1u);
            asm volatile("s_waitcnt vmcnt(0)" ::: "memory");
        } else {
            XB_SPIN(xb_ld(&bar[XB_XGEN(b.x)]) == gen, bar);
            __builtin_amdgcn_fence(__ATOMIC_ACQUIRE, "agent");
            asm volatile("s_waitcnt vmcnt(0)" ::: "memory");
        }
    }
    __syncthreads();
}

__device__ __forceinline__ unsigned pk2(float lo, float hi) { return (unsigned)f2bf(lo) | ((unsigned)f2bf(hi) << 16); }
__device__ __forceinline__ float wave_sum(float v) {
#pragma unroll
    for (int o = 1; o < 64; o <<= 1) v += __shfl_xor(v, o);
    return v;
}
__device__ __forceinline__ void p0_transpose_item(const float* W, int K, int N, int ldw, int coff, bf16_t* WT, int row_off, LAS float* scr, int item, int lane) {
    const int nblk = N / 32, kb = item / nblk, nb = item % nblk, k0 = 64 * kb, n0 = 32 * nb;
#pragma unroll 8
    for (int i = 0; i < 32; ++i) { const int kk = 2 * i + (lane >> 5); scr[kk * 33 + (lane & 31)] = W[(size_t)(k0 + kk) * ldw + coff + n0 + (lane & 31)]; }
    LDS_WAIT(); asm volatile("" ::: "memory");
    const int c = lane & 7;
#pragma unroll
    for (int j = 0; j < 4; ++j) { const int n = (lane >> 3) + 8 * j; const LAS float* s = scr + (8 * c) * 33 + n;
        v4u o; o.x = pk2(s[0 * 33], s[1 * 33]); o.y = pk2(s[2 * 33], s[3 * 33]); o.z = pk2(s[4 * 33], s[5 * 33]); o.w = pk2(s[6 * 33], s[7 * 33]);
        *(GAS v4u*)(WT + (size_t)(row_off + n0 + n) * K + k0 + 8 * c) = o; }
    LDS_WAIT(); asm volatile("" ::: "memory");
}
#ifndef PROMASK
#define PROMASK 15
#endif
struct Ptrs {
    const float *x, *p; const int* pos;
    const float *a_w_in, *a_b_ig, *a_b_fg, *a_hg, *a_w_out, *kv_w, *kv_b, *b_w_q, *b_b_q, *b_sinks, *b_w_o, *b_b_o, *mix_g, *mix_b, *w_up, *w_dn, *mlp_g, *mlp_b, *w_gate, *b_gate, *w_proj;
    float* R; unsigned char* ws;
};
#define WSP(T, off) ((T*)(P.ws + (off)))

__device__ __forceinline__ void phase_prologue(const Ptrs& P, LAS unsigned char* lds, int gw, int NGW, int lane, int wave) {
    LAS float* scr = (LAS float*)(lds + wave * 16384);
    if (PROMASK & 1) {
        int base = 0;
#define WJOB(Wp, WTo, K_, N_, ldw_, roff_) do { const int items_ = ((K_) / 64) * ((N_) / 32); const int first_ = ((gw - base) % NGW + NGW) % NGW; \
        for (int r_ = first_; r_ < items_; r_ += NGW) p0_transpose_item((Wp), (K_), (N_), (ldw_), 0, WSP(bf16_t, WTo), (roff_), scr, r_, lane); base += items_; } while (0)
        WJOB(P.a_w_in, W_IN, 1024, 3072, LDW_IN, 0);
        WJOB(P.a_w_out, W_OUT, 1024, 1024, 1024, 0);
        WJOB(P.w_up, W_UP0, 1024, 4096, 4096, 0);
        WJOB(P.w_dn, W_DN0, 4096, 1024, 1024, 0);
        WJOB(P.w_gate, W_G0, 1024, 1024, 1024, 0);
        WJOB(P.w_proj, W_P0, 256, 1024, 1024, 0);
        WJOB(P.b_w_q, W_QKV, 1024, 1024, 1024, 0);
        WJOB(P.kv_w, W_QKV, 1024, 512, 512, 1024);
        WJOB(P.b_w_o, W_O, 1024, 1024, 1024, 0);
        WJOB(P.w_up + (size_t)D * FF, W_UP1, 1024, 4096, 4096, 0);
        WJOB(P.w_dn + (size_t)D * FF, W_DN1, 4096, 1024, 1024, 0);
        WJOB(P.w_gate + (size_t)D * D, W_G1, 1024, 1024, 1024, 0);
        WJOB(P.w_proj + (size_t)PLE * D, W_P1, 256, 1024, 1024, 0);
#undef WJOB
    }
    if (PROMASK & 2) {
        bf16_t* Xb = WSP(bf16_t, WS_XB); float* gates = WSP(float, WS_GATES);
        const float big = P.a_b_ig[lane & 3], bfg = P.a_b_fg[lane & 3];
        for (int m = gw; m < M; m += NGW) {
            const GAS f32x4* xr = (const GAS f32x4*)(P.x + (size_t)m * D) + lane;
            float s[8];
#pragma unroll
            for (int g = 0; g < 8; ++g) s[g] = 0.f;
            GAS unsigned long long* o8 = (GAS unsigned long long*)(Xb + (size_t)m * D) + lane;
#pragma unroll
            for (int j = 0; j < 4; ++j) {
                const f32x4 v = xr[64 * j];
                o8[64 * j] = (unsigned long long)pk2(v.x, v.y) | ((unsigned long long)pk2(v.z, v.w) << 32);
#pragma unroll
                for (int q = 0; q < 4; ++q) {
                    const int c = 256 * j + 4 * lane + q;
                    const f32x4 w0 = *(const f32x4*)(P.a_w_in + (size_t)c * LDW_IN + NIN), w1 = *(const f32x4*)(P.a_w_in + (size_t)c * LDW_IN + NIN + 4);
                    const float xv = v[q];
                    s[0] += xv * w0.x; s[1] += xv * w0.y; s[2] += xv * w0.z; s[3] += xv * w0.w;
                    s[4] += xv * w1.x; s[5] += xv * w1.y; s[6] += xv * w1.z; s[7] += xv * w1.w;
                }
            }
#pragma unroll
            for (int g = 0; g < 8; ++g) s[g] = wave_sum(s[g]);
            float z = s[0];
#pragma unroll
            for (int g = 1; g < 8; ++g) z = (lane == g) ? s[g] : z;
            if (lane < 8) {
                float r;
                if (lane < 4) r = GATE_CAP * tanhf((z + big) / GATE_CAP);
                else { const float c = GATE_CAP * tanhf((z + bfg) / GATE_CAP); r = fminf(c, 0.f) - log1pf(expf(-fabsf(c))); }
                gates[(size_t)m * 8 + lane] = r;
            }
        }
    }
    if (PROMASK & 4) {
        const GAS f32x4* pin = (const GAS f32x4*)P.p; GAS unsigned long long* po = (GAS unsigned long long*)WSP(bf16_t, WS_PB);
        const size_t n4 = (size_t)2 * M * PLE / 4;
        for (size_t i = (size_t)gw * 64 + lane; i < n4; i += (size_t)NGW * 64) { const f32x4 v = pin[i]; po[i] = (unsigned long long)pk2(v.x, v.y) | ((unsigned long long)pk2(v.z, v.w) << 32); }
    }
    if (PROMASK & 8) {
        float* cs = WSP(float, WS_CS);
        for (int i = gw * 64 + lane; i < M * 8; i += NGW * 64) {
            const int m = i >> 3, j = i & 7;
            const float inv_freq = (float)pow(500000.0, -(double)j * (2.0 / 16.0));
            const float ang = (float)P.pos[m] * inv_freq;
            cs[(size_t)m * 16 + j] = (float)cos((double)ang);
            cs[(size_t)m * 16 + 8 + j] = (float)sin((double)ang);
        }
        float* bq = WSP(float, WS_BQKV);
        for (int i = gw * 64 + lane; i < 1536; i += NGW * 64) bq[i] = (i < 1024) ? P.b_b_q[i] : P.kv_b[i - 1024];
    }
}

__device__ __forceinline__ void phase_mlstm_naive(const Ptrs& P, LAS unsigned char* lds, int bid, int G, int tid) {
    const bf16_t* qkvo = WSP(bf16_t, WS_QKVO); const float* gates = WSP(float, WS_GATES); float* hraw = P.R;
    LAS float* qs = (LAS float*)lds; LAS float* ks = qs + 128; LAS float* rn = ks + 128; LAS float* rd = rn + 512;
    const int kg = tid >> 5, vc = tid & 31;
    for (int item = bid; item < 256; item += G) {
        const int b = item >> 5, h = (item >> 3) & 3, vs = item & 7;
        float C[8], n[8];
#pragma unroll
        for (int i = 0; i < 8; ++i) { C[i] = 0.f; n[i] = 0.f; }
        float m = 0.f;
        for (int s = 0; s < S; ++s) {
            const size_t row = (size_t)b * S + s;
            const bf16_t* r = qkvo + row * NIN;
            if (tid < 128) qs[tid] = bf2f(r[h * 128 + tid]); else if (tid < 256) ks[tid - 128] = bf2f(r[512 + h * 128 + (tid - 128)]);
            const float v = bf2f(r[1024 + h * 256 + vs * 32 + vc]);
            const float li = gates[row * 8 + h], lf = gates[row * 8 + 4 + h];
            __syncthreads();
            const float mn = fmaxf(lf + m, li), fp = expf(lf + m - mn), ip = expf(li - mn);
            m = mn;
            float pn = 0.f, pd = 0.f;
#pragma unroll
            for (int i = 0; i < 8; ++i) {
                const int kk = kg * 8 + i; const float kv = ks[kk], qv = qs[kk];
                C[i] = fp * C[i] + ip * kv * v; n[i] = fp * n[i] + ip * kv;
                pn += C[i] * qv; pd += n[i] * qv;
            }
            rn[kg * 32 + vc] = pn; rd[kg * 32 + vc] = pd;
            __syncthreads();
            if (tid < 32) {
                float num = 0.f, den = 0.f;
#pragma unroll
                for (int g = 0; g < 16; ++g) { num += rn[g * 32 + tid]; den += rd[g * 32 + tid]; }
                hraw[row * D + h * 256 + vs * 32 + tid] = num / fmaxf(fabsf(den), expf(-m));
            }
        }
        __syncthreads();
    }
}
__device__ __forceinline__ void phase_headnorm(const Ptrs& P, int gw, int NGW, int lane) {
    const float* hraw = P.R; const bf16_t* qkvo = WSP(bf16_t, WS_QKVO); bf16_t* hb = WSP(bf16_t, WS_HB);
    for (int it = gw; it < M * MH; it += NGW) {
        const int m = it >> 2, h = it & 3;
        float v[4]; float s = 0.f;
#pragma unroll
        for (int j = 0; j < 4; ++j) { v[j] = hraw[(size_t)m * D + h * 256 + j * 64 + lane]; s += v[j]; }
        s = wave_sum(s);
        const float mu = s * (1.f / 256.f); float q = 0.f;
#pragma unroll
        for (int j = 0; j < 4; ++j) { v[j] -= mu; q += v[j] * v[j]; }
        q = wave_sum(q);
        const float rs = 1.f / sqrtf(q * (1.f / 256.f) + LN_EPS);
#pragma unroll
        for (int j = 0; j < 4; ++j) {
            const int c = h * 256 + j * 64 + lane;
            const float o = bf2f(qkvo[(size_t)m * NIN + 2048 + c]);
            hb[(size_t)m * D + c] = f2bf(sigmoidf_(o) * (v[j] * rs * P.a_hg[c]));
        }
    }
}
__device__ __forceinline__ void phase_ln(const Ptrs& P, const float* g, const float* bta, int gw, int NGW, int lane) {
    float* R = P.R; bf16_t* xb = WSP(bf16_t, WS_XB);
    f32x4 gv[4], bv[4];
#pragma unroll
    for (int j = 0; j < 4; ++j) { gv[j] = *(const f32x4*)(g + 256 * j + 4 * lane); bv[j] = *(const f32x4*)(bta + 256 * j + 4 * lane); }
    for (int m = gw; m < M; m += NGW) {
        GAS f32x4* xr = (GAS f32x4*)(R + (size_t)m * D) + lane;
        f32x4 v[4]; float s = 0.f;
#pragma unroll
        for (int j = 0; j < 4; ++j) { v[j] = xr[64 * j]; s += (v[j].x + v[j].y) + (v[j].z + v[j].w); }
        const float mean = wave_sum(s) * (1.f / D); float s2 = 0.f;
#pragma unroll
        for (int j = 0; j < 4; ++j) { v[j] = v[j] - mean; s2 += (v[j].x * v[j].x + v[j].y * v[j].y) + (v[j].z * v[j].z + v[j].w * v[j].w); }
        const float rstd = 1.f / sqrtf(wave_sum(s2) * (1.f / D) + LN_EPS);
        GAS unsigned long long* o8 = (GAS unsigned long long*)(xb + (size_t)m * D) + lane;
#pragma unroll
        for (int j = 0; j < 4; ++j) { const f32x4 o = v[j] * rstd * gv[j] + bv[j]; xr[64 * j] = o; o8[64 * j] = (unsigned long long)pk2(o.x, o.y) | ((unsigned long long)pk2(o.z, o.w) << 32); }
    }
}
__device__ __forceinline__ void phase_attn_naive(const Ptrs& P, LAS unsigned char* lds, int gw, int NGW, int lane, int wave) {
    const bf16_t* qkv = WSP(bf16_t, WS_QKV1); const float* cs = WSP(float, WS_CS); bf16_t* ob = WSP(bf16_t, WS_OB);
    LAS float* qsh = (LAS float*)lds + wave * 64;
    for (int it = gw; it < M * AH; it += NGW) {
        const int m = it >> 4, hq = it & 15, kvh = hq >> 2, b = m >> 12, s = m & (S - 1);
        float qv = bf2f(qkv[(size_t)m * NQKV + hq * 64 + lane]);
        {
            const float other = __shfl_xor(qv, 8);
            if (lane < 8) qv = qv * cs[(size_t)m * 16 + lane] - other * cs[(size_t)m * 16 + 8 + lane];
            else if (lane < 16) qv = qv * cs[(size_t)m * 16 + lane - 8] + other * cs[(size_t)m * 16 + 8 + lane - 8];
        }
        qsh[lane] = qv;
        LDS_WAIT(); __builtin_amdgcn_wave_barrier();
        float sc[2]; bool val[2];
#pragma unroll
        for (int r = 0; r < 2; ++r) {
            const int off = lane + 64 * r, j = s - off; val[r] = (j >= 0); sc[r] = -INFINITY;
            if (val[r]) {
                const size_t mk = (size_t)b * S + j; const bf16_t* kr = qkv + mk * NQKV + 1024 + kvh * 64;
                float kk[64];
#pragma unroll
                for (int d = 0; d < 64; ++d) kk[d] = bf2f(kr[d]);
                float acc = 0.f;
#pragma unroll
                for (int d = 0; d < 8; ++d) {
                    const float c = cs[mk * 16 + d], sn = cs[mk * 16 + 8 + d];
                    const float r1 = kk[d] * c - kk[d + 8] * sn, r2 = kk[d + 8] * c + kk[d] * sn;
                    acc += qsh[d] * r1 + qsh[d + 8] * r2;
                }
#pragma unroll
                for (int d = 16; d < 64; ++d) acc += qsh[d] * kk[d];
                sc[r] = acc;
            }
        }
        const float snk = P.b_sinks[hq];
        float mx = fmaxf(fmaxf(sc[0], sc[1]), snk);
#pragma unroll
        for (int o = 32; o > 0; o >>= 1) mx = fmaxf(mx, __shfl_xor(mx, o));
        float e0 = val[0] ? expf(sc[0] - mx) : 0.f, e1 = val[1] ? expf(sc[1] - mx) : 0.f;
        const float sum = wave_sum(e0 + e1);
        const float inv = 1.f / (sum + expf(snk - mx));
        e0 *= inv; e1 *= inv;
        float out = 0.f;
        const int nk = (s + 1 < WIN) ? s + 1 : WIN;
        for (int off = 0; off < nk; ++off) {
            const float p = (off < 64) ? __shfl(e0, off) : __shfl(e1, off - 64);
            const size_t mk = (size_t)b * S + (s - off);
            out += p * bf2f(qkv[mk * NQKV + 1280 + kvh * 64 + lane]);
        }
        ob[(size_t)m * D + hq * 64 + lane] = f2bf(out);
        LDS_WAIT(); __builtin_amdgcn_wave_barrier();
    }
}
namespace ml {
typedef short bf16x8 __attribute__((ext_vector_type(8)));
typedef short s16x4 __attribute__((ext_vector_type(4)));
typedef short v4i16_t __attribute__((ext_vector_type(4)));
typedef float f32x16 __attribute__((ext_vector_type(16)));
typedef unsigned u32x4 __attribute__((ext_vector_type(4)));
typedef unsigned u32x2 __attribute__((ext_vector_type(2)));
constexpr int QK_STR = 272, K_OFF = 0, Q_OFF = 17408, KW_OFF = 34816, KW_STR = 320, V_OFF = 55296, V_STR = 576, HST_OFF = 0, HST_STR = 1040, TAB_OFF = 92160;
constexpr int T_F = 0, T_G = 64, T_M = 128, T_COEF = 200, T_DECAY = 208, T_CH = 256, T_DENP = 2816, T_HS = 3328;
constexpr float LOG2E = 1.4426950408889634f;
constexpr size_t WS_LN = 57u << 20;
#define MFMA32(a, b, c) __builtin_amdgcn_mfma_f32_32x32x16_bf16((a), (b), (c), 0, 0, 0)
__device__ __forceinline__ s16x4 vtr(const LAS unsigned char* p) { return __builtin_bit_cast(s16x4, __builtin_amdgcn_ds_read_tr16_b64_v4i16((LAS v4i16_t*)p)); }
__device__ __forceinline__ bf16x8 cat8(s16x4 lo, s16x4 hi) { return __builtin_shufflevector(lo, hi, 0, 1, 2, 3, 4, 5, 6, 7); }
__device__ __forceinline__ bf16x8 pack8(float a0, float a1, float a2, float a3, float a4, float a5, float a6, float a7) {
    u32x4 p; p.x = pg8::cvtpk(a0, a1); p.y = pg8::cvtpk(a2, a3); p.z = pg8::cvtpk(a4, a5); p.w = pg8::cvtpk(a6, a7); return __builtin_bit_cast(bf16x8, p); }
#define PACK_STEP(X, s) pack8((X)[8 * (s)], (X)[8 * (s) + 1], (X)[8 * (s) + 2], (X)[8 * (s) + 3], (X)[8 * (s) + 4], (X)[8 * (s) + 5], (X)[8 * (s) + 6], (X)[8 * (s) + 7])
__device__ __forceinline__ float wave_max(float v) {
#pragma unroll
    for (int o = 1; o < 64; o <<= 1) v = fmaxf(v, __shfl_xor(v, o));
    return v;
}
struct Pre { u32x4 q[2], k[2], v[4]; };

template <int PASS> __device__ __forceinline__ void mlstm_item(const Ptrs& P, LAS unsigned char* lds, int item, int tid, int lane, int wave) {
    const bf16_t* qkvo = WSP(bf16_t, WS_QKVO); const float* gates = WSP(float, WS_GATES);
    float* Lst = WSP(float, WS_ST); float* Lns = (float*)(P.ws + WS_LN);
    LAS float* tab = (LAS float*)(lds + TAB_OFF);
    const int bh = item >> 3, g = item & 7, b = bh >> 2, h = bh & 3;
    for (int c = wave; c < 64; c += 8) {
        const size_t row = (size_t)b * S + c * 64 + lane;
        const float lfv = gates[row * 8 + 4 + h], liv = gates[row * 8 + h];
        float bs = lfv;
#pragma unroll
        for (int o = 1; o < 64; o <<= 1) { const float t = __shfl_up(bs, o); if (lane >= o) bs += t; }
        const float gm = wave_max(liv - bs), Fc = __shfl(bs, 63);
        if (lane == 0) { tab[T_F + c] = Fc; tab[T_G + c] = gm; }
    }
    __syncthreads();
    if (tid == 0) { float m = 0.f; tab[T_M] = 0.f; for (int c = 0; c < 64; ++c) { m = tab[T_F + c] + fmaxf(m, tab[T_G + c]); tab[T_M + c + 1] = m; } }
    __syncthreads();
    if (PASS == 2 && tid < 8 && tid < g) { float e = tab[T_M + 8 * (tid + 1)] - tab[T_M + 8 * g]; for (int c = 8 * (tid + 1); c < 8 * g; ++c) e += tab[T_F + c]; tab[T_COEF + tid] = expf(e); }
    {
        const int c = 8 * g + wave; const size_t row = (size_t)b * S + c * 64 + lane;
        const float lfv = gates[row * 8 + 4 + h], liv = gates[row * 8 + h];
        float bs = lfv;
#pragma unroll
        for (int o = 1; o < 64; o <<= 1) { const float t = __shfl_up(bs, o); if (lane >= o) bs += t; }
        const float gv = liv - bs; float cm = gv;
#pragma unroll
        for (int o = 1; o < 64; o <<= 1) { const float t = __shfl_up(cm, o); if (lane >= o) cm = fmaxf(cm, t); }
        const float mc = tab[T_M + c], mn = tab[T_M + c + 1], Fc = tab[T_F + c], Mt = fmaxf(mc, cm);
        const int base = T_CH + wave * 320;
        tab[base + lane] = gv * LOG2E; tab[base + 64 + lane] = Mt * LOG2E; tab[base + 128 + lane] = expf(mc - Mt);
        tab[base + 192 + lane] = expf(-(bs + Mt)); tab[base + 256 + lane] = expf(Fc + gv - mn);
        if (lane == 0) tab[T_DECAY + wave] = expf(Fc + mc - mn);
    }
    __syncthreads();
    f32x16 C[4]; float nval = 0.f;
#pragma unroll
    for (int kt = 0; kt < 4; ++kt)
#pragma unroll
        for (int r = 0; r < 16; ++r) C[kt][r] = 0.f;
    if (PASS == 2) {
        for (int gp = 0; gp < g; ++gp) {
            const float cf = tab[T_COEF + gp];
            const float* Lp = Lst + ((size_t)((bh * 8 + gp) * 8 + wave) * 64) * 64 + lane;
#pragma unroll
            for (int kt = 0; kt < 4; ++kt)
#pragma unroll
                for (int r = 0; r < 16; ++r) C[kt][r] += cf * Lp[(size_t)(kt * 16 + r) * 64];
            nval += cf * Lns[(size_t)(bh * 8 + gp) * 128 + 16 * wave + (lane & 15)];
        }
    }
    const size_t m_seg = (size_t)b * S + (size_t)g * 512;
    Pre pr;
#define ML_LOAD(cj) do { const size_t m0_ = m_seg + (size_t)(cj) * 64; int tt_ = tid; asm volatile("" : "+v"(tt_)); \
        _Pragma("unroll") for (int i_ = 0; i_ < 2; ++i_) { const int idx_ = tt_ + 512 * i_, row_ = idx_ >> 4, ch_ = idx_ & 15; const bf16_t* rp_ = qkvo + (m0_ + row_) * NIN + h * 128 + ch_ * 8; \
            if (PASS == 2) pr.q[i_] = *(const u32x4*)rp_; pr.k[i_] = *(const u32x4*)(rp_ + 512); } \
        _Pragma("unroll") for (int i_ = 0; i_ < 4; ++i_) { const int idx_ = tt_ + 512 * i_, row_ = idx_ >> 5, ch_ = idx_ & 31; pr.v[i_] = *(const u32x4*)(qkvo + (m0_ + row_) * NIN + 1024 + h * 256 + ch_ * 8); } } while (0)
#define ML_STORE(cj) do { int tt_ = tid; asm volatile("" : "+v"(tt_)); \
        _Pragma("unroll") for (int i_ = 0; i_ < 2; ++i_) { const int idx_ = tt_ + 512 * i_, row_ = idx_ >> 4, ch_ = idx_ & 15; const int sw_ = row_ * QK_STR + (ch_ << 4); \
            if (PASS == 2) { *(LAS u32x4*)(lds + Q_OFF + sw_) = pr.q[i_]; *(LAS u32x4*)(lds + K_OFF + sw_) = pr.k[i_]; } \
            const float w_ = tab[T_CH + (cj) * 320 + 256 + row_]; const unsigned kw_[4] = {pr.k[i_].x, pr.k[i_].y, pr.k[i_].z, pr.k[i_].w}; u32x4 o_; \
            o_.x = pg8::cvtpk(__uint_as_float(kw_[0] << 16) * w_, __uint_as_float(kw_[0] & 0xffff0000u) * w_); o_.y = pg8::cvtpk(__uint_as_float(kw_[1] << 16) * w_, __uint_as_float(kw_[1] & 0xffff0000u) * w_); \
            o_.z = pg8::cvtpk(__uint_as_float(kw_[2] << 16) * w_, __uint_as_float(kw_[2] & 0xffff0000u) * w_); o_.w = pg8::cvtpk(__uint_as_float(kw_[3] << 16) * w_, __uint_as_float(kw_[3] & 0xffff0000u) * w_); \
            *(LAS u32x4*)(lds + KW_OFF + row_ * KW_STR + ch_ * 16) = o_; } \
        _Pragma("unroll") for (int i_ = 0; i_ < 4; ++i_) { const int idx_ = tt_ + 512 * i_, row_ = idx_ >> 5, ch_ = idx_ & 31; *(LAS u32x4*)(lds + V_OFF + row_ * V_STR + ch_ * 16) = pr.v[i_]; } } while (0)
    ML_LOAD(0);
    for (int cj = 0; cj < 8; ++cj) {
        int lane_ = lane; asm volatile("" : "+v"(lane_));
        const int tl = lane_ & 31, hh = lane_ >> 5;
        const int i16 = lane_ & 15, tq = i16 >> 2, tp = i16 & 3, blk = (lane_ >> 4) & 1;
        const int vtr_off = V_OFF + (4 * hh + tq) * V_STR + (32 * wave + 16 * blk + 4 * tp) * 2;
        const int kwtr_off = KW_OFF + (4 * hh + tq) * KW_STR + (16 * blk + 4 * tp) * 2;
        ML_STORE(cj);
        if (PASS == 1 && cj < 7) ML_LOAD(cj + 1);
        __syncthreads();
        const int tb = T_CH + cj * 320; const float decay = tab[T_DECAY + cj];
        f32x16 num[2]; float rs0 = 0.f, rs1 = 0.f; bf16x8 pf[3][2];
        if (PASS == 2) {
            {
                const int t = lane; const LAS unsigned char* qrow = lds + Q_OFF + t * QK_STR + 32 * wave;
                const u32x4 qa = *(const LAS u32x4*)(qrow), qb = *(const LAS u32x4*)(qrow + 16);
                const unsigned qw[8] = {qa.x, qa.y, qa.z, qa.w, qb.x, qb.y, qb.z, qb.w};
                float acc = 0.f;
#pragma unroll
                for (int i = 0; i < 8; ++i) { acc += __uint_as_float(qw[i] << 16) * __shfl(nval, 2 * i); acc += __uint_as_float(qw[i] & 0xffff0000u) * __shfl(nval, 2 * i + 1); }
                tab[T_DENP + wave * 64 + t] = acc;
            }
#pragma unroll
            for (int tile = 0; tile < 3; ++tile) {
                const int i = (tile == 2) ? 1 : 0, j = (tile == 0) ? 0 : 1;
                f32x16 st;
#pragma unroll
                for (int r = 0; r < 16; ++r) st[r] = 0.f;
                const int ra = 32 * i + tl, rb = 32 * j + tl;
#pragma unroll
                for (int ks = 0; ks < 8; ++ks) {
                    const int ch = 2 * ks + hh;
                    const bf16x8 ka = *(const LAS bf16x8*)(lds + K_OFF + ra * QK_STR + (ch << 4));
                    const bf16x8 qb = *(const LAS bf16x8*)(lds + Q_OFF + rb * QK_STR + (ch << 4));
                    st = MFMA32(ka, qb, st);
                }
                const float Ml = tab[tb + 64 + 32 * j + tl];
                float rs = 0.f;
#pragma unroll
                for (int a = 0; a < 4; ++a) {
                    const f32x4 gl = *(const LAS f32x4*)(tab + tb + 32 * i + 8 * a + 4 * hh);
#pragma unroll
                    for (int q = 0; q < 4; ++q) {
                        float pv = st[4 * a + q] * __builtin_amdgcn_exp2f(gl[q] - Ml);
                        if (i == j) pv = (8 * a + 4 * hh + q <= tl) ? pv : 0.f;
                        st[4 * a + q] = pv; rs += pv;
                    }
                }
                if (j == 0) rs0 += rs; else rs1 += rs;
                pf[tile][0] = PACK_STEP(st, 0); pf[tile][1] = PACK_STEP(st, 1);
                __builtin_amdgcn_sched_barrier(0);
            }
#pragma unroll
            for (int j = 0; j < 2; ++j) {
#pragma unroll
                for (int r = 0; r < 16; ++r) num[j][r] = 0.f;
                const int row = 32 * j + tl; const LAS unsigned char* qrow = lds + Q_OFF + row * QK_STR + 8 * hh;
#pragma unroll
                for (int kt = 0; kt < 4; ++kt)
#pragma unroll
                    for (int s2 = 0; s2 < 2; ++s2) {
                        const int ch = 4 * kt + 2 * s2;
                        const s16x4 lo = *(const LAS s16x4*)(qrow + (ch << 4)), hi = *(const LAS s16x4*)(qrow + ((ch + 1) << 4));
                        num[j] = MFMA32(cat8(lo, hi), PACK_STEP(C[kt], s2), num[j]);
                    }
                __builtin_amdgcn_sched_barrier(0);
            }
            rs0 += __shfl_xor(rs0, 32); rs1 += __shfl_xor(rs1, 32);
#pragma unroll
            for (int j = 0; j < 2; ++j)
#pragma unroll
                for (int a = 0; a < 4; ++a) { const f32x4 it = *(const LAS f32x4*)(tab + tb + 128 + 32 * j + 8 * a + 4 * hh);
#pragma unroll
                    for (int q = 0; q < 4; ++q) num[j][4 * a + q] *= it[q]; }
        }
        bf16x8 vf[4];
#pragma unroll
        for (int ks = 0; ks < 4; ++ks) vf[ks] = cat8(vtr(lds + vtr_off + 16 * ks * V_STR), vtr(lds + vtr_off + (16 * ks + 8) * V_STR));
        if (PASS == 2) {
            num[0] = MFMA32(pf[0][0], vf[0], num[0]); num[0] = MFMA32(pf[0][1], vf[1], num[0]);
            num[1] = MFMA32(pf[1][0], vf[0], num[1]); num[1] = MFMA32(pf[1][1], vf[1], num[1]);
            num[1] = MFMA32(pf[2][0], vf[2], num[1]); num[1] = MFMA32(pf[2][1], vf[3], num[1]);
        }
#pragma unroll
        for (int kt = 0; kt < 4; ++kt) {
#pragma unroll
            for (int r = 0; r < 16; ++r) C[kt][r] *= decay;
#pragma unroll
            for (int ks = 0; ks < 4; ++ks) {
                const bf16x8 ka = cat8(vtr(lds + kwtr_off + 16 * ks * KW_STR + 64 * kt), vtr(lds + kwtr_off + (16 * ks + 8) * KW_STR + 64 * kt));
                C[kt] = MFMA32(ka, vf[ks], C[kt]);
            }
            __builtin_amdgcn_sched_barrier(0);
        }
        {
            const int kl = lane & 15, sq = lane >> 4; float part = 0.f;
            const LAS unsigned char* kp = lds + KW_OFF + (16 * sq) * KW_STR + (16 * wave + kl) * 2;
#pragma unroll
            for (int s = 0; s < 16; ++s) part += __uint_as_float((unsigned)(*(const LAS unsigned short*)(kp + s * KW_STR)) << 16);
            part += __shfl_xor(part, 16); part += __shfl_xor(part, 32);
            nval = decay * nval + part;
        }
        if (PASS == 2) {
            __syncthreads();
            if (cj < 7) ML_LOAD(cj + 1);
            {
                const int t = lane; float qn = 0.f;
#pragma unroll
                for (int w8 = 0; w8 < 8; ++w8) qn += tab[T_DENP + w8 * 64 + t];
                const float den = ((lane < 32) ? rs0 : rs1) + tab[tb + 128 + t] * qn;
                tab[T_HS + wave * 64 + t] = 1.0f / fmaxf(fabsf(den), tab[tb + 192 + t]);
            }
            LDS_WAIT();
#pragma unroll
            for (int j = 0; j < 2; ++j)
#pragma unroll
                for (int a = 0; a < 4; ++a) { const f32x4 hs = *(const LAS f32x4*)(tab + T_HS + wave * 64 + 32 * j + 8 * a + 4 * hh);
#pragma unroll
                    for (int q = 0; q < 4; ++q) { const int t = 32 * j + 8 * a + 4 * hh + q;
                        *(LAS float*)(lds + HST_OFF + t * HST_STR + (32 * wave + tl) * 4) = num[j][4 * a + q] * hs[q]; } }
            __syncthreads();
            {
                const f32x4 hg = *(const f32x4*)(P.a_hg + h * 256 + 4 * lane);
                bf16_t* hb = WSP(bf16_t, WS_HB);
#pragma unroll
                for (int rr = 0; rr < 8; ++rr) {
                    const int t = 8 * wave + rr; const size_t m = m_seg + (size_t)cj * 64 + t;
                    f32x4 x = *(const LAS f32x4*)(lds + HST_OFF + t * HST_STR + 16 * lane);
                    const u32x2 ow = *(const u32x2*)(qkvo + m * NIN + 2048 + h * 256 + 4 * lane);
                    const float mu = wave_sum((x[0] + x[1]) + (x[2] + x[3])) * (1.f / 256.f);
                    x = x - mu;
                    const float rstd = 1.f / sqrtf(wave_sum((x[0] * x[0] + x[1] * x[1]) + (x[2] * x[2] + x[3] * x[3])) * (1.f / 256.f) + LN_EPS);
                    const float o0 = __uint_as_float(ow.x << 16), o1 = __uint_as_float(ow.x & 0xffff0000u), o2 = __uint_as_float(ow.y << 16), o3 = __uint_as_float(ow.y & 0xffff0000u);
                    u32x2 w2; w2.x = pg8::cvtpk(pg8::fast_sigmoid(o0) * (x[0] * rstd * hg[0]), pg8::fast_sigmoid(o1) * (x[1] * rstd * hg[1]));
                    w2.y = pg8::cvtpk(pg8::fast_sigmoid(o2) * (x[2] * rstd * hg[2]), pg8::fast_sigmoid(o3) * (x[3] * rstd * hg[3]));
                    *(u32x2*)(hb + m * D + h * 256 + 4 * lane) = w2;
                }
            }
        }
        __syncthreads();
    }
#undef ML_LOAD
#undef ML_STORE
    if (PASS == 1) {
        float* Lp = Lst + ((size_t)((bh * 8 + g) * 8 + wave) * 64) * 64 + lane;
#pragma unroll
        for (int kt = 0; kt < 4; ++kt)
#pragma unroll
            for (int r = 0; r < 16; ++r) Lp[(size_t)(kt * 16 + r) * 64] = C[kt][r];
        if (lane < 16) Lns[(size_t)(bh * 8 + g) * 128 + 16 * wave + lane] = nval;
    }
}
template <int PASS> __device__ __forceinline__ void phase_mlstm(const Ptrs& P, LAS unsigned char* lds, int vcu, int G, int tid, int lane, int wave) {
    { int t_ = threadIdx.x; asm volatile("" : "+v"(t_)); tid = t_; lane = t_ & 63; wave = __builtin_amdgcn_readfirstlane(t_ >> 6); }
    for (int item = vcu; item < 256; item += G) {
        if (PASS == 1 && (item & 7) == 7) continue;
        mlstm_item<PASS>(P, lds, item, tid, lane, wave);
        __syncthreads();
    }
}
#undef MFMA32
}
constexpr int NWAVES = 8;
constexpr int RING_OFF = 0, RING_BYTES = 131072;
constexpr int LDSCTL_OFF = RING_BYTES, MISC_OFF = LDSCTL_OFF + 320;
constexpr int LDS_BYTES = 147456;
constexpr int CW_TMO = 0, CW_CODE = 1, CW_BAR = 4096;
constexpr size_t CTL_ZERO_BYTES = 1u << 20;
#ifndef MK_ONE_LAUNCH
#define MK_ONE_LAUNCH 1
#endif
constexpr int NPHASE = 18;

struct Args { const void* in[24]; float* out; unsigned char* ws; int ph_lo, ph_hi; };

__global__ void __launch_bounds__(NWAVES * 64, 2) mk_fwd(Args args) {
    extern __shared__ __attribute__((aligned(16))) unsigned char lds_raw[];
    LAS unsigned char* lds = (LAS unsigned char*)lds_raw;
    volatile LAS unsigned* MISC = (volatile LAS unsigned*)(lds + MISC_OFF);
    const int tid = threadIdx.x, lane = tid & 63, wave = __builtin_amdgcn_readfirstlane(tid >> 6);
    const int G = gridDim.x, bx = blockIdx.x;
    const int vcu = (G % 8 == 0) ? (bx % 8) * (G / 8) + bx / 8 : bx;
    const int gw = vcu * NWAVES + wave, NGW = G * NWAVES;
    Ptrs P;
    P.x = (const float*)args.in[0]; P.p = (const float*)args.in[1]; P.pos = (const int*)args.in[2];
    P.a_w_in = (const float*)args.in[3]; P.a_b_ig = (const float*)args.in[4]; P.a_b_fg = (const float*)args.in[5]; P.a_hg = (const float*)args.in[6]; P.a_w_out = (const float*)args.in[7];
    P.kv_w = (const float*)args.in[8]; P.kv_b = (const float*)args.in[9]; P.b_w_q = (const float*)args.in[10]; P.b_b_q = (const float*)args.in[11]; P.b_sinks = (const float*)args.in[12];
    P.b_w_o = (const float*)args.in[13]; P.b_b_o = (const float*)args.in[14]; P.mix_g = (const float*)args.in[15]; P.mix_b = (const float*)args.in[16];
    P.w_up = (const float*)args.in[17]; P.w_dn = (const float*)args.in[18]; P.mlp_g = (const float*)args.in[19]; P.mlp_b = (const float*)args.in[20];
    P.w_gate = (const float*)args.in[21]; P.b_gate = (const float*)args.in[22]; P.w_proj = (const float*)args.in[23];
    P.R = args.out; P.ws = args.ws;
    gu32* ctl = (gu32*)(P.ws + WS_CTL);
    for (int u = tid; u < (LDS_BYTES - LDSCTL_OFF) / 4; u += NWAVES * 64) ((LAS unsigned*)(lds + LDSCTL_OFF))[u] = 0u;
    __syncthreads();
    XcdBarrier bar; bar.bar = (unsigned*)(ctl + CW_BAR); bar.x = 0; bar.st = nullptr;
    if (MK_ONE_LAUNCH) bar = xcd_barrier_post((unsigned*)(ctl + CW_BAR), MISC + 8);
    const int lo = args.ph_lo, hi = args.ph_hi;
#define IN(k) (lo <= (k) && (k) < hi)
#define SEAM(k) do { if (IN(k) && IN((k) + 1)) xcd_barrier(bar); } while (0)
    bf16_t* Xb = WSP(bf16_t, WS_XB); bf16_t* U = WSP(bf16_t, WS_U); bf16_t* Pb = WSP(bf16_t, WS_PB); bf16_t* Hh = WSP(bf16_t, WS_HH);
    bf16_t* QKVO = WSP(bf16_t, WS_QKVO); bf16_t* HB = WSP(bf16_t, WS_HB); bf16_t* X3b = WSP(bf16_t, WS_X3B); bf16_t* QKV1 = WSP(bf16_t, WS_QKV1); bf16_t* OB = WSP(bf16_t, WS_OB);
#define GEMM(EpiT, E, Ap, Btp, N_, K_) do { pg8::Gemm g_{}; g_.A = (Ap); g_.Bt = (Btp); g_.M = M; g_.N = (N_); g_.K = (K_); pg8::StaticOrder S_; S_.init(M, (N_), G, bx); \
        pg8::gemm_phase<EpiT, pg8::StaticOrder, true, true>(lds + RING_OFF, g_, S_, (E)); } while (0)

    if (IN(0)) { phase_prologue(P, lds, gw, NGW, lane, wave); } SEAM(0);
    if (IN(1)) {
        { pg8::EpiBf16G<0> E{}; E.O = QKVO; E.ldc = NIN; E.nscale = 512; E.scale = 0.08838834764831845f; GEMM(pg8::EpiBf16G<0>, E, Xb, WSP(bf16_t, W_IN), NIN, D); }
        { pg8::EpiBf16G<0> E{}; E.O = U; E.ldc = D; E.nscale = 0; E.scale = 1.f; GEMM(pg8::EpiBf16G<0>, E, Pb, WSP(bf16_t, W_P0), D, PLE); }
    } SEAM(1);
    if (IN(2)) { ml::phase_mlstm<1>(P, lds, vcu, G, tid, lane, wave); } SEAM(2);
    if (IN(3)) { ml::phase_mlstm<2>(P, lds, vcu, G, tid, lane, wave); } SEAM(3);
    if (IN(4)) { pg8::EpiRes E{}; E.base = P.x; E.R = P.R; E.alpha = ALPHA; GEMM(pg8::EpiRes, E, HB, WSP(bf16_t, W_OUT), D, D); } SEAM(4);
    if (IN(5)) { phase_ln(P, P.mix_g, P.mix_b, gw, NGW, lane); } SEAM(5);
    if (IN(6)) { pg8::EpiBf16G<1> E{}; E.O = Hh; E.ldc = FF; E.nscale = 0; E.scale = 1.f; GEMM(pg8::EpiBf16G<1>, E, Xb, WSP(bf16_t, W_UP0), FF, D); } SEAM(6);
    if (IN(7)) { pg8::EpiRes E{}; E.base = P.R; E.R = P.R; E.alpha = ALPHA; GEMM(pg8::EpiRes, E, Hh, WSP(bf16_t, W_DN0), D, FF); } SEAM(7);
    if (IN(8)) { phase_ln(P, P.mlp_g, P.mlp_b, gw, NGW, lane); } SEAM(8);
    if (IN(9)) { pg8::EpiPle E{}; E.R = P.R; E.bias = P.b_gate; E.U = U; E.Xb = X3b; GEMM(pg8::EpiPle, E, Xb, WSP(bf16_t, W_G0), D, D); } SEAM(9);
    if (IN(10)) {
        { pg8::EpiBf16G<0> E{}; E.O = QKV1; E.bias = WSP(float, WS_BQKV); E.ldc = NQKV; E.nscale = 1024; E.scale = 0.125f; GEMM(pg8::EpiBf16G<0>, E, X3b, WSP(bf16_t, W_QKV), NQKV, D); }
        { pg8::EpiBf16G<0> E{}; E.O = U; E.ldc = D; E.nscale = 0; E.scale = 1.f; GEMM(pg8::EpiBf16G<0>, E, Pb + (size_t)M * PLE, WSP(bf16_t, W_P1), D, PLE); }
    } SEAM(10);
    if (IN(11)) { phase_attn_naive(P, lds, gw, NGW, lane, wave); } SEAM(11);
    if (IN(12)) { pg8::EpiRes E{}; E.base = P.R; E.R = P.R; E.alpha = ALPHA; E.bias = P.b_b_o; GEMM(pg8::EpiRes, E, OB, WSP(bf16_t, W_O), D, D); } SEAM(12);
    if (IN(13)) { phase_ln(P, P.mix_g + D, P.mix_b + D, gw, NGW, lane); } SEAM(13);
    if (IN(14)) { pg8::EpiBf16G<1> E{}; E.O = Hh; E.ldc = FF; E.nscale = 0; E.scale = 1.f; GEMM(pg8::EpiBf16G<1>, E, Xb, WSP(bf16_t, W_UP1), FF, D); } SEAM(14);
    if (IN(15)) { pg8::EpiRes E{}; E.base = P.R; E.R = P.R; E.alpha = ALPHA; GEMM(pg8::EpiRes, E, Hh, WSP(bf16_t, W_DN1), D, FF); } SEAM(15);
    if (IN(16)) { phase_ln(P, P.mlp_g + D, P.mlp_b + D, gw, NGW, lane); } SEAM(16);
    if (IN(17)) { pg8::EpiPle E{}; E.R = P.R; E.bias = P.b_gate + D; E.U = U; E.Xb = nullptr; GEMM(pg8::EpiPle, E, Xb, WSP(bf16_t, W_G1), D, D); }
#undef IN
#undef SEAM
#undef GEMM
}

extern "C" void kernel_launch(void* const* d_in, const int* in_sizes, int n_in, void* d_out, int out_size, void* d_ws, size_t ws_size, hipStream_t stream) {
    static int grid = 0;
    if (grid == 0) {
        if (n_in != 24 || in_sizes[0] != M * D || out_size != M * D || ws_size < WS_END) {
            fprintf(stderr, "kernel_launch: unexpected shapes: n_in %d in0 %d out %d ws %zu; nothing launched\n", n_in, n_in > 0 ? in_sizes[0] : -1, out_size, ws_size); grid = -1; return; }
        int dev = 0, cus = 0, per_cu = 0;
        if (hipGetDevice(&dev) != hipSuccess || hipDeviceGetAttribute(&cus, hipDeviceAttributeMultiprocessorCount, dev) != hipSuccess) { fprintf(stderr, "kernel_launch: device query failed\n"); grid = -1; return; }
        if (hipFuncSetAttribute((const void*)mk_fwd, hipFuncAttributeMaxDynamicSharedMemorySize, LDS_BYTES) != hipSuccess) { fprintf(stderr, "kernel_launch: hipFuncSetAttribute failed\n"); grid = -1; return; }
        if (hipOccupancyMaxActiveBlocksPerMultiprocessor(&per_cu, (const void*)mk_fwd, NWAVES * 64, LDS_BYTES) != hipSuccess || per_cu < 1)
            fprintf(stderr, "kernel_launch: note: occupancy query reports %d workgroups per CU\n", per_cu);
        (void)hipGetLastError();
        grid = cus;
    }
    if (grid < 0) return;
    if (hipMemsetAsync((char*)d_ws + WS_CTL, 0, CTL_ZERO_BYTES, stream) != hipSuccess) { fprintf(stderr, "kernel_launch: memset failed\n"); return; }
    Args a{};
    for (int i = 0; i < 24; ++i) a.in[i] = d_in[i];
    a.out = (float*)d_out; a.ws = (unsigned char*)d_ws;
#if MK_ONE_LAUNCH
    a.ph_lo = 0; a.ph_hi = NPHASE;
    hipLaunchKernelGGL(mk_fwd, dim3(grid), dim3(NWAVES * 64), LDS_BYTES, stream, a);
#else
    for (int ph = 0; ph < NPHASE; ++ph) { a.ph_lo = ph; a.ph_hi = ph + 1; hipLaunchKernelGGL(mk_fwd, dim3(grid), dim3(NWAVES * 64), LDS_BYTES, stream, a); }
#endif
    const hipError_t le = hipPeekAtLastError();
    if (le != hipSuccess) fprintf(stderr, "kernel_launch: launch failed: %s\n", hipGetErrorName(le));
}
```

```cpp
#include <hip/hip_runtime.h>
#include <cstdio>
#include <cstdint>

typedef unsigned short bf16_t;
typedef float f32x4 __attribute__((ext_vector_type(4)));

namespace cfg {
constexpr int D = 1024, NB = 8, S = 4096, M = NB * S;
constexpr int MH = 4, MDV = 256, MDK = 128, NIN = 3072, LDW_IN = 3080;
constexpr int AH = 16, AKV = 4, AHD = 64, WIN = 128, NQKV = 1536;
constexpr int FF = 4096, PLE = 256;
constexpr float LN_EPS = 1e-5f;
constexpr float ALPHA = 1.41421356237309515f;
constexpr float GATE_CAP = 15.0f;
constexpr size_t MiB = 1u << 20;
constexpr size_t WS_CTL = 0;
constexpr size_t WS_GATES = 1 * MiB;
constexpr size_t WS_CS = 2 * MiB;
constexpr size_t WS_BQKV = 56 * MiB;
constexpr size_t WS_W = 4 * MiB;
constexpr size_t W_IN = WS_W;
constexpr size_t W_OUT = W_IN + 6 * MiB;
constexpr size_t W_UP0 = W_OUT + 2 * MiB;
constexpr size_t W_DN0 = W_UP0 + 8 * MiB;
constexpr size_t W_G0 = W_DN0 + 8 * MiB;
constexpr size_t W_P0 = W_G0 + 2 * MiB;
constexpr size_t W_QKV = W_P0 + MiB / 2;
constexpr size_t W_O = W_QKV + 3 * MiB;
constexpr size_t W_UP1 = W_O + 2 * MiB;
constexpr size_t W_DN1 = W_UP1 + 8 * MiB;
constexpr size_t W_G1 = W_DN1 + 8 * MiB;
constexpr size_t W_P1 = W_G1 + 2 * MiB;
constexpr size_t WS_XB = 64 * MiB;
constexpr size_t WS_U = 128 * MiB;
constexpr size_t WS_PB = 192 * MiB;
constexpr size_t WS_ST = 224 * MiB;
constexpr size_t WS_HH = 256 * MiB;
constexpr size_t WS_QKVO = WS_HH;
constexpr size_t WS_HB = WS_HH + 192 * MiB;
constexpr size_t WS_X3B = WS_HH;
constexpr size_t WS_QKV1 = WS_HH + 64 * MiB;
constexpr size_t WS_OB = WS_HH + 192 * MiB;
constexpr size_t WS_END = 512 * MiB;
}
using namespace cfg;

__device__ __forceinline__ float bf2f(bf16_t v) { return __uint_as_float((unsigned)v << 16); }
__device__ __forceinline__ bf16_t f2bf(float f) { unsigned u = __float_as_uint(f); return (bf16_t)((u + 0x7fffu + ((u >> 16) & 1u)) >> 16); }
__device__ __forceinline__ float sigmoidf_(float z) { return 1.f / (1.f + expf(-z)); }

namespace pg8 {
#define PG8_LAS __attribute__((address_space(3)))
typedef unsigned short bf16_t;
typedef short bf16x8 __attribute__((ext_vector_type(8)));
typedef float f32x4 __attribute__((ext_vector_type(4)));
typedef unsigned u32x4 __attribute__((ext_vector_type(4)));
constexpr int BM = 256, BK = 64, HALF = 128, HTB = HALF * BK * 2  , STAGE_BYTES = 8 * HTB, NXCD = 8, WGM = 8;

__host__ __device__ __forceinline__ int lds_byte(int r, int c) { const int st = (r >> 4) * 2 + (c >> 5), rr = r & 15, cc = c & 31, ob = rr * 64 + cc * 2; return st * 1024 + (ob ^ (((ob >> 9) & 1) << 5)); }
__host__ __device__ __forceinline__ void stage_rc(int b, int& R, int& C) { const int st = b / 1024, sb = b % 1024, swz = sb ^ (((sb >> 9) & 1) << 5); R = (st >> 1) * 16 + swz / 64; C = (st & 1) * 32 + (swz % 64) / 2; }
__host__ __device__ __forceinline__ int perm32(int rho) { const int n = rho >> 4, i = rho & 15; return 8 * (i >> 2) + 4 * n + (i & 3); }

struct Unit { int pm, pn; };
struct Gemm { const bf16_t* A; const bf16_t* Bt; int M, N, K, pad; };

struct StaticOrder {
    int nM, nN, nwg, G, c;
    __host__ __device__ void init(int M, int N, int G_, int c_) { nM = M / BM; nN = N / BM; nwg = nM * nN; G = G_; c = c_; }
    __host__ __device__ bool next(int i, Unit& u) const {
        const long L = (long)i * G + c; if (L >= nwg) return false;
        int wgid = (int)L; { const int q = nwg / NXCD, r = nwg % NXCD, xcd = wgid % NXCD, off = wgid / NXCD; wgid = (xcd < r ? xcd * (q + 1) : r * (q + 1) + (xcd - r) * q) + off; }
        const int nig = WGM * nN, gid = wgid / nig, fm = gid * WGM, gsz = (nM - fm) < WGM ? (nM - fm) : WGM;
        u.pm = fm + ((wgid % nig) % gsz); u.pn = (wgid % nig) / gsz; return true;
    }
    __device__ __forceinline__ void a_ready(const Unit&) const {}
    __device__ __forceinline__ void done(const Unit&) const {}
};

template <class Epi, class Sched, bool ALIGN_EPI = false, bool SP2 = false>
__device__ __forceinline__ void gemm_phase(PG8_LAS unsigned char* lds, const Gemm g, const Sched& S, const Epi& E) {
    int tid_ = threadIdx.x; asm volatile("" : "+v"(tid_));
    const int tid = tid_, wid = __builtin_amdgcn_readfirstlane(tid >> 6), lane = tid & 63, wr = wid >> 2, wc = wid & 3, fr = lane & 15, fq = lane >> 4;
    const int K = g.K, nt = K / BK;
    unsigned voffA[2], voffB[2];
#pragma unroll
    for (int i = 0; i < 2; ++i) { int R, C; stage_rc(tid * 16 + i * 8192, R, C); const int Rb = Epi::PERM ? ((R & ~31) + perm32(R & 31)) : R;
        voffA[i] = (unsigned)(R * K + C) * 2u; voffB[i] = (unsigned)(Rb * K + C) * 2u; }
    const size_t kstep = (size_t)(BK * 2);
    const size_t hstep = (size_t)HALF * K * 2;
    const size_t tstep = 2 * hstep;
    const unsigned ldsw = (unsigned)wid * 1024u;
    const int aoff = lds_byte(wr * 64 + fr, fq * 8), boff = lds_byte(wc * 32 + fr, fq * 8);
#define PG8_SA(b, h) (((b) * 2 + (h)) * HTB)
#define PG8_SB(b, h) ((4 + (b) * 2 + (h)) * HTB)
#define PG8_STAGE(bufoff, gbase, voff) do { _Pragma("unroll") for (int _i = 0; _i < 2; ++_i) \
        __builtin_amdgcn_global_load_lds((const unsigned*)((const char*)(gbase) + (voff)[_i]), (PG8_LAS unsigned*)(lds + (bufoff) + ldsw + _i * 8192), 16, 0, 0); } while (0)
#define PG8_LDA(dst, b, h) do { _Pragma("unroll") for (int m = 0; m < 4; ++m) _Pragma("unroll") for (int k = 0; k < 2; ++k) dst[m][k] = *(const PG8_LAS bf16x8*)(lds + PG8_SA(b, h) + aoff + m * 2048 + k * 1024); } while (0)
#define PG8_LDB(dst, b, h) do { _Pragma("unroll") for (int n = 0; n < 2; ++n) _Pragma("unroll") for (int k = 0; k < 2; ++k) dst[n][k] = *(const PG8_LAS bf16x8*)(lds + PG8_SB(b, h) + boff + n * 2048 + k * 1024); } while (0)
#define PG8_MMA(ai, bj, At, Bt) do { __builtin_amdgcn_s_setprio(1); _Pragma("unroll") for (int m = 0; m < 4; ++m) _Pragma("unroll") for (int n = 0; n < 2; ++n) _Pragma("unroll") for (int k = 0; k < 2; ++k) \
        acc[ai][bj][m][n] = __builtin_amdgcn_mfma_f32_16x16x32_bf16(Bt[n][k], At[m][k], acc[ai][bj][m][n], 0, 0, 0); __builtin_amdgcn_s_setprio(0); } while (0)
#define PG8_WAIT_V(n) asm volatile("s_waitcnt vmcnt(" #n ")" ::: "memory")
#define PG8_WAIT_L(n) asm volatile("s_waitcnt lgkmcnt(" #n ")" ::: "memory")
#define PG8_BAR __builtin_amdgcn_s_barrier()
#define PG8_SCHED __builtin_amdgcn_sched_barrier(0)
    Unit cur, nxt; int ui = 0;
    if (!S.next(0, cur)) return;
    f32x4 acc[2][2][4][2];
#pragma unroll
    for (int a = 0; a < 2; ++a)
#pragma unroll
        for (int b = 0; b < 2; ++b)
#pragma unroll
            for (int m = 0; m < 4; ++m)
#pragma unroll
                for (int n = 0; n < 2; ++n) acc[a][b][m][n] = (f32x4){0.f, 0.f, 0.f, 0.f};
    bf16x8 At[4][2], B0[2][2], B1[2][2];
    const char* cA = (const char*)g.A + (size_t)cur.pm * tstep; const char* cB = (const char*)g.Bt + (size_t)cur.pn * tstep;
    S.a_ready(cur);
    if constexpr (SP2) {
        PG8_STAGE(PG8_SB(0, 0), cB, voffB); PG8_STAGE(PG8_SB(0, 1), cB + hstep, voffB); PG8_STAGE(PG8_SA(0, 0), cA, voffA); PG8_STAGE(PG8_SA(0, 1), cA + hstep, voffA);
        if (wr == 1) PG8_BAR;
        PG8_WAIT_V(2); PG8_BAR;
        PG8_STAGE(PG8_SB(1, 0), cB + kstep, voffB); PG8_STAGE(PG8_SA(1, 0), cA + kstep, voffA); PG8_STAGE(PG8_SB(1, 1), cB + hstep + kstep, voffB);
        PG8_WAIT_V(6); PG8_BAR;
    } else {
        PG8_STAGE(PG8_SB(0, 0), cB, voffB); PG8_STAGE(PG8_SA(0, 0), cA, voffA); PG8_STAGE(PG8_SB(0, 1), cB + hstep, voffB); PG8_STAGE(PG8_SA(0, 1), cA + hstep, voffA);
        if (wr == 1) PG8_BAR;
        PG8_WAIT_V(4); PG8_BAR;
        PG8_STAGE(PG8_SB(1, 0), cB + kstep, voffB); PG8_STAGE(PG8_SA(1, 0), cA + kstep, voffA); PG8_STAGE(PG8_SB(1, 1), cB + hstep + kstep, voffB);
        PG8_WAIT_V(6); PG8_BAR;
    }
    for (;;) {
        const bool has_next = S.next(ui + 1, nxt);
        const char* nA = has_next ? (const char*)g.A + (size_t)nxt.pm * tstep : cA; const char* nB = has_next ? (const char*)g.Bt + (size_t)nxt.pn * tstep : cB;
        for (int t = 0; t < nt; t += 2) {
            const bool last = (t == nt - 2);
            const char* a1 = cA + (size_t)(t + 1) * kstep;
            const char* a2 = last ? nA : cA + (size_t)(t + 2) * kstep; const char* b2 = last ? nB : cB + (size_t)(t + 2) * kstep;
            const char* a3 = a2 + kstep; const char* b3 = b2 + kstep;
            if (last && has_next) S.a_ready(nxt);
            if constexpr (SP2) {
            PG8_LDB(B0, 0, 0); PG8_LDB(B1, 0, 1); PG8_SCHED; PG8_LDA(At, 0, 0); PG8_STAGE(PG8_SA(1, 1), a1 + hstep, voffA);
            PG8_WAIT_V(8); PG8_WAIT_L(0); PG8_BAR; PG8_MMA(0, 0, At, B0); PG8_MMA(0, 1, At, B1); PG8_BAR; PG8_SCHED;
            PG8_LDA(At, 0, 1); PG8_STAGE(PG8_SB(0, 0), b2, voffB); PG8_STAGE(PG8_SB(0, 1), b2 + hstep, voffB); PG8_STAGE(PG8_SA(0, 0), a2, voffA);
            PG8_WAIT_V(8); PG8_WAIT_L(0); PG8_BAR; PG8_MMA(1, 0, At, B0); PG8_MMA(1, 1, At, B1); PG8_BAR; PG8_SCHED;
            PG8_LDB(B0, 1, 0); PG8_LDB(B1, 1, 1); PG8_SCHED; PG8_LDA(At, 1, 0); PG8_STAGE(PG8_SA(0, 1), a2 + hstep, voffA);
            PG8_WAIT_V(8); PG8_WAIT_L(0); PG8_BAR; PG8_MMA(0, 0, At, B0); PG8_MMA(0, 1, At, B1); PG8_BAR; PG8_SCHED;
            PG8_LDA(At, 1, 1); PG8_STAGE(PG8_SB(1, 0), b3, voffB); PG8_STAGE(PG8_SB(1, 1), b3 + hstep, voffB); PG8_STAGE(PG8_SA(1, 0), a3, voffA);
            PG8_WAIT_V(8); PG8_WAIT_L(0); PG8_BAR; PG8_MMA(1, 0, At, B0); PG8_MMA(1, 1, At, B1); PG8_BAR; PG8_SCHED;
            } else {
            PG8_LDB(B0, 0, 0); PG8_SCHED; PG8_LDA(At, 0, 0); PG8_STAGE(PG8_SA(1, 1), a1 + hstep, voffA);
            PG8_WAIT_L(8); PG8_BAR; PG8_WAIT_L(0); PG8_MMA(0, 0, At, B0); PG8_BAR; PG8_SCHED;
            PG8_LDB(B1, 0, 1); PG8_STAGE(PG8_SB(0, 0), b2, voffB);
            PG8_BAR; PG8_WAIT_L(0); PG8_MMA(0, 1, At, B1); PG8_BAR;
            PG8_LDA(At, 0, 1); PG8_STAGE(PG8_SA(0, 0), a2, voffA);
            PG8_BAR; PG8_WAIT_L(0); PG8_MMA(1, 0, At, B0); PG8_BAR; PG8_SCHED;
            PG8_STAGE(PG8_SB(0, 1), b2 + hstep, voffB);
            PG8_WAIT_V(6); PG8_BAR; PG8_MMA(1, 1, At, B1); PG8_BAR;
            PG8_LDB(B0, 1, 0); PG8_SCHED; PG8_LDA(At, 1, 0); PG8_STAGE(PG8_SA(0, 1), a2 + hstep, voffA);
            PG8_WAIT_L(8); PG8_BAR; PG8_WAIT_L(0); PG8_MMA(0, 0, At, B0); PG8_BAR; PG8_SCHED;
            PG8_LDB(B1, 1, 1); PG8_STAGE(PG8_SB(1, 0), b3, voffB);
            PG8_BAR; PG8_WAIT_L(0); PG8_MMA(0, 1, At, B1); PG8_BAR;
            PG8_LDA(At, 1, 1); PG8_STAGE(PG8_SA(1, 0), a3, voffA);
            PG8_BAR; PG8_WAIT_L(0); PG8_MMA(1, 0, At, B0); PG8_BAR; PG8_SCHED;
            PG8_STAGE(PG8_SB(1, 1), b3 + hstep, voffB);
            PG8_WAIT_V(6); PG8_BAR; PG8_MMA(1, 1, At, B1); PG8_BAR;
            }
        }
        if constexpr (ALIGN_EPI) { if (wr == 0) PG8_BAR; }
        if constexpr (!Epi::AFTER_DRAIN) { E(acc, cur, wr, wc, fr, fq); S.done(cur); }
        if (!has_next) break;
#pragma unroll
        for (int a = 0; a < 2; ++a)
#pragma unroll
            for (int b = 0; b < 2; ++b)
#pragma unroll
                for (int m = 0; m < 4; ++m)
#pragma unroll
                    for (int n = 0; n < 2; ++n) acc[a][b][m][n] = (f32x4){0.f, 0.f, 0.f, 0.f};
        cur = nxt; cA = nA; cB = nB; ++ui;
        if constexpr (ALIGN_EPI) { if (wr == 1) PG8_BAR; }
    }
    PG8_WAIT_V(0);
    if constexpr (!ALIGN_EPI) { if (wr == 0) PG8_BAR; }
    PG8_BAR;
    if constexpr (Epi::AFTER_DRAIN) { E.fused(acc, cur, wr, wc, fr, fq, lds, wid, lane); S.done(cur); }
#undef PG8_SA
#undef PG8_SB
#undef PG8_STAGE
#undef PG8_LDA
#undef PG8_LDB
#undef PG8_MMA
#undef PG8_WAIT_V
#undef PG8_WAIT_L
#undef PG8_BAR
#undef PG8_SCHED
}
}
namespace pg8 {
typedef float f32x2 __attribute__((ext_vector_type(2)));
typedef unsigned u32x2 __attribute__((ext_vector_type(2)));
typedef __bf16 bf16x2_t __attribute__((ext_vector_type(2)));
__device__ __forceinline__ unsigned cvtpk(float lo, float hi) { f32x2 v = {lo, hi}; bf16x2_t b = __builtin_convertvector(v, bf16x2_t); return __builtin_bit_cast(unsigned, b); }
__device__ __forceinline__ float fast_sigmoid(float z) { return __builtin_amdgcn_rcpf(1.0f + __builtin_amdgcn_exp2f(-1.4426950408889634f * z)); }
template <int ACT> struct EpiBf16G {
    static constexpr bool PERM = true, AFTER_DRAIN = false;
    bf16_t* O; const float* bias; int ldc, nscale; float scale; int pad;
    __device__ __forceinline__ void operator()(const f32x4 (&acc)[2][2][4][2], const Unit& u, int wr, int wc, int fr, int fq) const {
        const int row0 = u.pm * BM + wr * 64 + fr, col0 = u.pn * BM + wc * 32 + 8 * fq;
        f32x4 bv[2][2]; float sc[2];
#pragma unroll
        for (int bj = 0; bj < 2; ++bj) { sc[bj] = (col0 + bj * HALF < nscale) ? scale : 1.f;
#pragma unroll
            for (int n = 0; n < 2; ++n) bv[bj][n] = bias ? *(const f32x4*)(bias + col0 + bj * HALF + 4 * n) : (f32x4){0.f, 0.f, 0.f, 0.f}; }
#pragma unroll
        for (int ai = 0; ai < 2; ++ai)
#pragma unroll
            for (int m = 0; m < 4; ++m) { bf16_t* rowp = O + (size_t)(row0 + ai * HALF + m * 16) * ldc + col0;
#pragma unroll
                for (int bj = 0; bj < 2; ++bj) { f32x4 v0 = acc[ai][bj][m][0] + bv[bj][0], v1 = acc[ai][bj][m][1] + bv[bj][1];
                    if (ACT == 1) { v0 = __builtin_elementwise_max(v0, (f32x4){0.f, 0.f, 0.f, 0.f}); v1 = __builtin_elementwise_max(v1, (f32x4){0.f, 0.f, 0.f, 0.f}); v0 = v0 * v0; v1 = v1 * v1; }
                    v0 = v0 * sc[bj]; v1 = v1 * sc[bj];
                    u32x4 w; w.x = cvtpk(v0[0], v0[1]); w.y = cvtpk(v0[2], v0[3]); w.z = cvtpk(v1[0], v1[1]); w.w = cvtpk(v1[2], v1[3]);
                    *(u32x4*)(rowp + bj * HALF) = w; } }
    }
};
struct EpiRes {
    static constexpr bool PERM = false, AFTER_DRAIN = false;
    const float* base; float* R; const float* bias; float alpha; int pad;
    __device__ __forceinline__ void operator()(const f32x4 (&acc)[2][2][4][2], const Unit& u, int wr, int wc, int fr, int fq) const {
        const int col0 = u.pn * BM + wc * 32 + 4 * fq;
        f32x4 bv[2][2];
#pragma unroll
        for (int bj = 0; bj < 2; ++bj)
#pragma unroll
            for (int n = 0; n < 2; ++n) bv[bj][n] = bias ? *(const f32x4*)(bias + col0 + bj * HALF + n * 16) : (f32x4){0.f, 0.f, 0.f, 0.f};
#pragma unroll
        for (int ai = 0; ai < 2; ++ai)
#pragma unroll
            for (int m = 0; m < 4; ++m) { const size_t off = (size_t)(u.pm * BM + ai * HALF + wr * 64 + m * 16 + fr) * 1024 + col0;
#pragma unroll
                for (int bj = 0; bj < 2; ++bj)
#pragma unroll
                    for (int n = 0; n < 2; ++n) { const size_t idx = off + bj * HALF + n * 16; const f32x4 b = *(const f32x4*)(base + idx);
                        *(f32x4*)(R + idx) = b * alpha + acc[ai][bj][m][n] + bv[bj][n]; }
                if (m & 1) asm volatile("" ::: "memory"); }
    }
};
struct EpiPle {
    static constexpr bool PERM = false, AFTER_DRAIN = false;
    float* R; const float* bias; const bf16_t* U; bf16_t* Xb;
    __device__ __forceinline__ void operator()(const f32x4 (&acc)[2][2][4][2], const Unit& u, int wr, int wc, int fr, int fq) const {
        const int col0 = u.pn * BM + wc * 32 + 4 * fq;
        f32x4 bv[2][2];
#pragma unroll
        for (int bj = 0; bj < 2; ++bj)
#pragma unroll
            for (int n = 0; n < 2; ++n) bv[bj][n] = *(const f32x4*)(bias + col0 + bj * HALF + n * 16);
#pragma unroll
        for (int ai = 0; ai < 2; ++ai)
#pragma unroll
            for (int m = 0; m < 4; ++m) { const size_t off = (size_t)(u.pm * BM + ai * HALF + wr * 64 + m * 16 + fr) * 1024 + col0;
#pragma unroll
                for (int bj = 0; bj < 2; ++bj)
#pragma unroll
                    for (int n = 0; n < 2; ++n) { const size_t idx = off + bj * HALF + n * 16; const f32x4 r0 = *(const f32x4*)(R + idx); const u32x2 uw = *(const u32x2*)(U + idx);
                        const f32x4 z = acc[ai][bj][m][n] + bv[bj][n];
                        f32x4 uv; uv[0] = __uint_as_float(uw.x << 16); uv[1] = __uint_as_float(uw.x & 0xffff0000u); uv[2] = __uint_as_float(uw.y << 16); uv[3] = __uint_as_float(uw.y & 0xffff0000u);
                        f32x4 r; r[0] = r0[0] + fast_sigmoid(z[0]) * uv[0]; r[1] = r0[1] + fast_sigmoid(z[1]) * uv[1]; r[2] = r0[2] + fast_sigmoid(z[2]) * uv[2]; r[3] = r0[3] + fast_sigmoid(z[3]) * uv[3];
                        *(f32x4*)(R + idx) = r;
                        if (Xb) { u32x2 w; w.x = cvtpk(r[0], r[1]); w.y = cvtpk(r[2], r[3]); *(u32x2*)(Xb + idx) = w; } }
                if (m & 1) asm volatile("" ::: "memory"); }
    }
};
}

#define GAS __attribute__((address_space(1)))
#define LAS __attribute__((address_space(3)))

typedef unsigned v4u __attribute__((ext_vector_type(4)));


typedef GAS unsigned gu32;
typedef GAS unsigned long long gu64;
#define RLX_AGENT __ATOMIC_RELAXED, __HIP_MEMORY_SCOPE_AGENT
#define LDS_WAIT() asm volatile("s_waitcnt lgkmcnt(0)" ::: "memory")
#define VM_WAIT() asm volatile("s_waitcnt vmcnt(0)" ::: "memory")
__device__ __forceinline__ unsigned long long rt() { return __builtin_amdgcn_s_memrealtime(); }

#define XB_TMO      128
#define XB_XCNT(j)  (256  + 64 * (j))
#define XB_XSUB(j)  (1280 + 64 * (j))
#define XB_XGEN(j)  (2304 + 64 * (j))
#define XB_TOP      3328
#define XB_TOPGEN   3392
#define XCD_BAR_WORDS 3456
#define XB_SPIN_CAP (1u << 18)

__device__ __forceinline__ unsigned xb_ld(unsigned* p)              { return __hip_atomic_load(p, __ATOMIC_RELAXED, __HIP_MEMORY_SCOPE_AGENT); }
__device__ __forceinline__ unsigned xb_add(unsigned* p, unsigned v) { return __hip_atomic_fetch_add(p, v, __ATOMIC_RELAXED, __HIP_MEMORY_SCOPE_AGENT); }
__device__ __forceinline__ unsigned xb_xcc_id() { return (unsigned)__builtin_amdgcn_s_getreg((3 << 11) | 20) & 0xFu; }
#define XB_SPIN(cond, bar) do { unsigned _sp = 0; while (cond) { __builtin_amdgcn_s_sleep(1); \
    if ((++_sp & 255u) == 0u) { if (xb_ld(&(bar)[XB_TMO])) break; if (_sp > XB_SPIN_CAP) { atomicAdd(&(bar)[XB_TMO], 1u); break; } } } } while (0)

struct XcdBarrier {
    unsigned* bar; unsigned x;
    volatile LAS unsigned* st;
};

__device__ __forceinline__ XcdBarrier xcd_barrier_post(unsigned* bar, volatile LAS unsigned* st) {
    XcdBarrier b; b.bar = bar; b.x = xb_xcc_id(); b.st = st;
    if (threadIdx.x == 0) (void)xb_add(&bar[XB_XCNT(b.x)], 1u);
    return b;
}
__device__ __forceinline__ void xcd_barrier_complete(unsigned* bar, unsigned x, unsigned& nloc, unsigned& nx) {
    const unsigned G = gridDim.x * gridDim.y * gridDim.z;
    unsigned sum, cnt, mine, sp = 0u;
    for (;;) {
        sum = 0u; cnt = 0u; mine = 0u;
#pragma unroll
        for (unsigned j = 0; j < 16; ++j) { const unsigned c = xb_ld(&bar[XB_XCNT(j)]); sum += c; cnt += (c > 0u) ? 1u : 0u; mine = (j == x) ? c : mine; }
        if (sum == G) break;
        __builtin_amdgcn_s_sleep(1);
        if ((++sp & 255u) == 0u) { if (xb_ld(&bar[XB_TMO])) break; if (sp > XB_SPIN_CAP) { atomicAdd(&bar[XB_TMO], 1u); break; } }
    }
    nloc = mine > 0u ? mine : 1u; nx = cnt > 0u ? cnt : 1u;
}

__device__ __forceinline__ void xcd_barrier(const XcdBarrier& b) {
    asm volatile("s_waitcnt vmcnt(0)" ::: "memory");
    __syncthreads();
    if (threadIdx.x == 0) {
        unsigned* bar = b.bar;
        __builtin_amdgcn_s_waitcnt(0);
        unsigned nloc = b.st[0], nx = b.st[1];
        if (nloc == 0u) { xcd_barrier_complete(bar, b.x, nloc, nx); b.st[0] = nloc; b.st[1] = nx; }
        const unsigned old = xb_add(&bar[XB_XSUB(b.x)], 1u);
        const unsigned gen = old / nloc;
        if (old + 1u == (gen + 1u) * nloc) {
            __builtin_amdgcn_fence(__ATOMIC_RELEASE, "agent");
            asm volatile("s_waitcnt vmcnt(0)" ::: "memory");
            const unsigned og = xb_add(&bar[XB_TOP], 1u);
            const unsigned tg = og / nx;
            if (og + 1u == (tg + 1u) * nx) xb_add(&bar[XB_TOPGEN], 1u);
            else XB_SPIN(xb_ld(&bar[XB_TOPGEN]) == tg, bar);
            __builtin_amdgcn_fence(__ATOMIC_ACQUIRE, "agent");
            xb_add(&bar[XB_XGEN(b.x)], 1u);
            asm volatile("s_waitcnt vmcnt(0)" ::: "memory");
        } else {
            XB_SPIN(xb_ld(&bar[XB_XGEN(b.x)]) == gen, bar);
            __builtin_amdgcn_fence(__ATOMIC_ACQUIRE, "agent");
            asm volatile("s_waitcnt vmcnt(0)" ::: "memory");
        }
    }
    __syncthreads();
}

__device__ __forceinline__ unsigned pk2(float lo, float hi) { return (unsigned)f2bf(lo) | ((unsigned)f2bf(hi) << 16); }
__device__ __forceinline__ float wave_sum(float v) {
#pragma unroll
    for (int o = 1; o < 64; o <<= 1) v += __shfl_xor(v, o);
    return v;
}
__device__ __forceinline__ void p0_transpose_item(const float* W, int K, int N, int ldw, int coff, bf16_t* WT, int row_off, LAS float* scr, int item, int lane) {
    const int nblk = N / 32, kb = item / nblk, nb = item % nblk, k0 = 64 * kb, n0 = 32 * nb;
#pragma unroll 8
    for (int i = 0; i < 32; ++i) { const int kk = 2 * i + (lane >> 5); scr[kk * 33 + (lane & 31)] = W[(size_t)(k0 + kk) * ldw + coff + n0 + (lane & 31)]; }
    LDS_WAIT(); asm volatile("" ::: "memory");
    const int c = lane & 7;
#pragma unroll
    for (int j = 0; j < 4; ++j) { const int n = (lane >> 3) + 8 * j; const LAS float* s = scr + (8 * c) * 33 + n;
        v4u o; o.x = pk2(s[0 * 33], s[1 * 33]); o.y = pk2(s[2 * 33], s[3 * 33]); o.z = pk2(s[4 * 33], s[5 * 33]); o.w = pk2(s[6 * 33], s[7 * 33]);
        *(GAS v4u*)(WT + (size_t)(row_off + n0 + n) * K + k0 + 8 * c) = o; }
    LDS_WAIT(); asm volatile("" ::: "memory");
}
#ifndef PROMASK
#define PROMASK 15
#endif
struct Ptrs {
    const float *x, *p; const int* pos;
    const float *a_w_in, *a_b_ig, *a_b_fg, *a_hg, *a_w_out, *kv_w, *kv_b, *b_w_q, *b_b_q, *b_sinks, *b_w_o, *b_b_o, *mix_g, *mix_b, *w_up, *w_dn, *mlp_g, *mlp_b, *w_gate, *b_gate, *w_proj;
    float* R; unsigned char* ws;
};
#define WSP(T, off) ((T*)(P.ws + (off)))

__device__ __forceinline__ void phase_prologue(const Ptrs& P, LAS unsigned char* lds, int gw, int NGW, int lane, int wave) {
    LAS float* scr = (LAS float*)(lds + wave * 16384);
    if (PROMASK & 1) {
        int base = 0;
#define WJOB(Wp, WTo, K_, N_, ldw_, roff_) do { const int items_ = ((K_) / 64) * ((N_) / 32); const int first_ = ((gw - base) % NGW + NGW) % NGW; \
        for (int r_ = first_; r_ < items_; r_ += NGW) p0_transpose_item((Wp), (K_), (N_), (ldw_), 0, WSP(bf16_t, WTo), (roff_), scr, r_, lane); base += items_; } while (0)
        WJOB(P.a_w_in, W_IN, 1024, 3072, LDW_IN, 0);
        WJOB(P.a_w_out, W_OUT, 1024, 1024, 1024, 0);
        WJOB(P.w_up, W_UP0, 1024, 4096, 4096, 0);
        WJOB(P.w_dn, W_DN0, 4096, 1024, 1024, 0);
        WJOB(P.w_gate, W_G0, 1024, 1024, 1024, 0);
        WJOB(P.w_proj, W_P0, 256, 1024, 1024, 0);
        WJOB(P.b_w_q, W_QKV, 1024, 1024, 1024, 0);
        WJOB(P.kv_w, W_QKV, 1024, 512, 512, 1024);
        WJOB(P.b_w_o, W_O, 1024, 1024, 1024, 0);
        WJOB(P.w_up + (size_t)D * FF, W_UP1, 1024, 4096, 4096, 0);
        WJOB(P.w_dn + (size_t)D * FF, W_DN1, 4096, 1024, 1024, 0);
        WJOB(P.w_gate + (size_t)D * D, W_G1, 1024, 1024, 1024, 0);
        WJOB(P.w_proj + (size_t)PLE * D, W_P1, 256, 1024, 1024, 0);
#undef WJOB
    }
    if (PROMASK & 2) {
        bf16_t* Xb = WSP(bf16_t, WS_XB); float* gates = WSP(float, WS_GATES);
        const float big = P.a_b_ig[lane & 3], bfg = P.a_b_fg[lane & 3];
        for (int m = gw; m < M; m += NGW) {
            const GAS f32x4* xr = (const GAS f32x4*)(P.x + (size_t)m * D) + lane;
            float s[8];
#pragma unroll
            for (int g = 0; g < 8; ++g) s[g] = 0.f;
            GAS unsigned long long* o8 = (GAS unsigned long long*)(Xb + (size_t)m * D) + lane;
#pragma unroll
            for (int j = 0; j < 4; ++j) {
                const f32x4 v = xr[64 * j];
                o8[64 * j] = (unsigned long long)pk2(v.x, v.y) | ((unsigned long long)pk2(v.z, v.w) << 32);
#pragma unroll
                for (int q = 0; q < 4; ++q) {
                    const int c = 256 * j + 4 * lane + q;
                    const f32x4 w0 = *(const f32x4*)(P.a_w_in + (size_t)c * LDW_IN + NIN), w1 = *(const f32x4*)(P.a_w_in + (size_t)c * LDW_IN + NIN + 4);
                    const float xv = v[q];
                    s[0] += xv * w0.x; s[1] += xv * w0.y; s[2] += xv * w0.z; s[3] += xv * w0.w;
                    s[4] += xv * w1.x; s[5] += xv * w1.y; s[6] += xv * w1.z; s[7] += xv * w1.w;
                }
            }
#pragma unroll
            for (int g = 0; g < 8; ++g) s[g] = wave_sum(s[g]);
            float z = s[0];
#pragma unroll
            for (int g = 1; g < 8; ++g) z = (lane == g) ? s[g] : z;
            if (lane < 8) {
                float r;
                if (lane < 4) r = GATE_CAP * tanhf((z + big) / GATE_CAP);
                else { const float c = GATE_CAP * tanhf((z + bfg) / GATE_CAP); r = fminf(c, 0.f) - log1pf(expf(-fabsf(c))); }
                gates[(size_t)m * 8 + lane] = r;
            }
        }
    }
    if (PROMASK & 4) {
        const GAS f32x4* pin = (const GAS f32x4*)P.p; GAS unsigned long long* po = (GAS unsigned long long*)WSP(bf16_t, WS_PB);
        const size_t n4 = (size_t)2 * M * PLE / 4;
        for (size_t i = (size_t)gw * 64 + lane; i < n4; i += (size_t)NGW * 64) { const f32x4 v = pin[i]; po[i] = (unsigned long long)pk2(v.x, v.y) | ((unsigned long long)pk2(v.z, v.w) << 32); }
    }
    if (PROMASK & 8) {
        float* cs = WSP(float, WS_CS);
        for (int i = gw * 64 + lane; i < M * 8; i += NGW * 64) {
            const int m = i >> 3, j = i & 7;
            const float inv_freq = (float)pow(500000.0, -(double)j * (2.0 / 16.0));
            const float ang = (float)P.pos[m] * inv_freq;
            cs[(size_t)m * 16 + j] = (float)cos((double)ang);
            cs[(size_t)m * 16 + 8 + j] = (float)sin((double)ang);
        }
        float* bq = WSP(float, WS_BQKV);
        for (int i = gw * 64 + lane; i < 1536; i += NGW * 64) bq[i] = (i < 1024) ? P.b_b_q[i] : P.kv_b[i - 1024];
    }
}

__device__ __forceinline__ void phase_mlstm_naive(const Ptrs& P, LAS unsigned char* lds, int bid, int G, int tid) {
    const bf16_t* qkvo = WSP(bf16_t, WS_QKVO); const float* gates = WSP(float, WS_GATES); float* hraw = P.R;
    LAS float* qs = (LAS float*)lds; LAS float* ks = qs + 128; LAS float* rn = ks + 128; LAS float* rd = rn + 512;
    const int kg = tid >> 5, vc = tid & 31;
    for (int item = bid; item < 256; item += G) {
        const int b = item >> 5, h = (item >> 3) & 3, vs = item & 7;
        float C[8], n[8];
#pragma unroll
        for (int i = 0; i < 8; ++i) { C[i] = 0.f; n[i] = 0.f; }
        float m = 0.f;
        for (int s = 0; s < S; ++s) {
            const size_t row = (size_t)b * S + s;
            const bf16_t* r = qkvo + row * NIN;
            if (tid < 128) qs[tid] = bf2f(r[h * 128 + tid]); else if (tid < 256) ks[tid - 128] = bf2f(r[512 + h * 128 + (tid - 128)]);
            const float v = bf2f(r[1024 + h * 256 + vs * 32 + vc]);
            const float li = gates[row * 8 + h], lf = gates[row * 8 + 4 + h];
            __syncthreads();
            const float mn = fmaxf(lf + m, li), fp = expf(lf + m - mn), ip = expf(li - mn);
            m = mn;
            float pn = 0.f, pd = 0.f;
#pragma unroll
            for (int i = 0; i < 8; ++i) {
                const int kk = kg * 8 + i; const float kv = ks[kk], qv = qs[kk];
                C[i] = fp * C[i] + ip * kv * v; n[i] = fp * n[i] + ip * kv;
                pn += C[i] * qv; pd += n[i] * qv;
            }
            rn[kg * 32 + vc] = pn; rd[kg * 32 + vc] = pd;
            __syncthreads();
            if (tid < 32) {
                float num = 0.f, den = 0.f;
#pragma unroll
                for (int g = 0; g < 16; ++g) { num += rn[g * 32 + tid]; den += rd[g * 32 + tid]; }
                hraw[row * D + h * 256 + vs * 32 + tid] = num / fmaxf(fabsf(den), expf(-m));
            }
        }
        __syncthreads();
    }
}
__device__ __forceinline__ void phase_headnorm(const Ptrs& P, int gw, int NGW, int lane) {
    const float* hraw = P.R; const bf16_t* qkvo = WSP(bf16_t, WS_QKVO); bf16_t* hb = WSP(bf16_t, WS_HB);
    for (int it = gw; it < M * MH; it += NGW) {
        const int m = it >> 2, h = it & 3;
        float v[4]; float s = 0.f;
#pragma unroll
        for (int j = 0; j < 4; ++j) { v[j] = hraw[(size_t)m * D + h * 256 + j * 64 + lane]; s += v[j]; }
        s = wave_sum(s);
        const float mu = s * (1.f / 256.f); float q = 0.f;
#pragma unroll
        for (int j = 0; j < 4; ++j) { v[j] -= mu; q += v[j] * v[j]; }
        q = wave_sum(q);
        const float rs = 1.f / sqrtf(q * (1.f / 256.f) + LN_EPS);
#pragma unroll
        for (int j = 0; j < 4; ++j) {
            const int c = h * 256 + j * 64 + lane;
            const float o = bf2f(qkvo[(size_t)m * NIN + 2048 + c]);
            hb[(size_t)m * D + c] = f2bf(sigmoidf_(o) * (v[j] * rs * P.a_hg[c]));
        }
    }
}
__device__ __forceinline__ void phase_ln(const Ptrs& P, const float* g, const float* bta, int gw, int NGW, int lane) {
    float* R = P.R; bf16_t* xb = WSP(bf16_t, WS_XB);
    f32x4 gv[4], bv[4];
#pragma unroll
    for (int j = 0; j < 4; ++j) { gv[j] = *(const f32x4*)(g + 256 * j + 4 * lane); bv[j] = *(const f32x4*)(bta + 256 * j + 4 * lane); }
    for (int m = gw; m < M; m += NGW) {
        GAS f32x4* xr = (GAS f32x4*)(R + (size_t)m * D) + lane;
        f32x4 v[4]; float s = 0.f;
#pragma unroll
        for (int j = 0; j < 4; ++j) { v[j] = xr[64 * j]; s += (v[j].x + v[j].y) + (v[j].z + v[j].w); }
        const float mean = wave_sum(s) * (1.f / D); float s2 = 0.f;
#pragma unroll
        for (int j = 0; j < 4; ++j) { v[j] = v[j] - mean; s2 += (v[j].x * v[j].x + v[j].y * v[j].y) + (v[j].z * v[j].z + v[j].w * v[j].w); }
        const float rstd = 1.f / sqrtf(wave_sum(s2) * (1.f / D) + LN_EPS);
        GAS unsigned long long* o8 = (GAS unsigned long long*)(xb + (size_t)m * D) + lane;
#pragma unroll
        for (int j = 0; j < 4; ++j) { const f32x4 o = v[j] * rstd * gv[j] + bv[j]; xr[64 * j] = o; o8[64 * j] = (unsigned long long)pk2(o.x, o.y) | ((unsigned long long)pk2(o.z, o.w) << 32); }
    }
}
__device__ __forceinline__ void phase_attn_naive(const Ptrs& P, LAS unsigned char* lds, int gw, int NGW, int lane, int wave) {
    const bf16_t* qkv = WSP(bf16_t, WS_QKV1); const float* cs = WSP(float, WS_CS); bf16_t* ob = WSP(bf16_t, WS_OB);
    LAS float* qsh = (LAS float*)lds + wave * 64;
    for (int it = gw; it < M * AH; it += NGW) {
        const int m = it >> 4, hq = it & 15, kvh = hq >> 2, b = m >> 12, s = m & (S - 1);
        float qv = bf2f(qkv[(size_t)m * NQKV + hq * 64 + lane]);
        {
            const float other = __shfl_xor(qv, 8);
            if (lane < 8) qv = qv * cs[(size_t)m * 16 + lane] - other * cs[(size_t)m * 16 + 8 + lane];
            else if (lane < 16) qv = qv * cs[(size_t)m * 16 + lane - 8] + other * cs[(size_t)m * 16 + 8 + lane - 8];
        }
        qsh[lane] = qv;
        LDS_WAIT(); __builtin_amdgcn_wave_barrier();
        float sc[2]; bool val[2];
#pragma unroll
        for (int r = 0; r < 2; ++r) {
            const int off = lane + 64 * r, j = s - off; val[r] = (j >= 0); sc[r] = -INFINITY;
            if (val[r]) {
                const size_t mk = (size_t)b * S + j; const bf16_t* kr = qkv + mk * NQKV + 1024 + kvh * 64;
                float kk[64];
#pragma unroll
                for (int d = 0; d < 64; ++d) kk[d] = bf2f(kr[d]);
                float acc = 0.f;
#pragma unroll
                for (int d = 0; d < 8; ++d) {
                    const float c = cs[mk * 16 + d], sn = cs[mk * 16 + 8 + d];
                    const float r1 = kk[d] * c - kk[d + 8] * sn, r2 = kk[d + 8] * c + kk[d] * sn;
                    acc += qsh[d] * r1 + qsh[d + 8] * r2;
                }
#pragma unroll
                for (int d = 16; d < 64; ++d) acc += qsh[d] * kk[d];
                sc[r] = acc;
            }
        }
        const float snk = P.b_sinks[hq];
        float mx = fmaxf(fmaxf(sc[0], sc[1]), snk);
#pragma unroll
        for (int o = 32; o > 0; o >>= 1) mx = fmaxf(mx, __shfl_xor(mx, o));
        float e0 = val[0] ? expf(sc[0] - mx) : 0.f, e1 = val[1] ? expf(sc[1] - mx) : 0.f;
        const float sum = wave_sum(e0 + e1);
        const float inv = 1.f / (sum + expf(snk - mx));
        e0 *= inv; e1 *= inv;
        float out = 0.f;
        const int nk = (s + 1 < WIN) ? s + 1 : WIN;
        for (int off = 0; off < nk; ++off) {
            const float p = (off < 64) ? __shfl(e0, off) : __shfl(e1, off - 64);
            const size_t mk = (size_t)b * S + (s - off);
            out += p * bf2f(qkv[mk * NQKV + 1280 + kvh * 64 + lane]);
        }
        ob[(size_t)m * D + hq * 64 + lane] = f2bf(out);
        LDS_WAIT(); __builtin_amdgcn_wave_barrier();
    }
}
namespace ml {
typedef short bf16x8 __attribute__((ext_vector_type(8)));
typedef short s16x4 __attribute__((ext_vector_type(4)));
typedef short v4i16_t __attribute__((ext_vector_type(4)));
typedef float f32x16 __attribute__((ext_vector_type(16)));
typedef unsigned u32x4 __attribute__((ext_vector_type(4)));
typedef unsigned u32x2 __attribute__((ext_vector_type(2)));
constexpr int QK_STR = 272, K_OFF = 0, Q_OFF = 17408, KW_OFF = 34816, KW_STR = 320, V_OFF = 55296, V_STR = 576, HST_OFF = 0, HST_STR = 1040, TAB_OFF = 92160;
constexpr int T_F = 0, T_G = 64, T_M = 128, T_COEF = 200, T_DECAY = 208, T_CH = 256, T_DENP = 2816, T_HS = 3328;
constexpr float LOG2E = 1.4426950408889634f;
constexpr size_t WS_LN = 57u << 20;
#define MFMA32(a, b, c) __builtin_amdgcn_mfma_f32_32x32x16_bf16((a), (b), (c), 0, 0, 0)
__device__ __forceinline__ s16x4 vtr(const LAS unsigned char* p) { return __builtin_bit_cast(s16x4, __builtin_amdgcn_ds_read_tr16_b64_v4i16((LAS v4i16_t*)p)); }
__device__ __forceinline__ bf16x8 cat8(s16x4 lo, s16x4 hi) { return __builtin_shufflevector(lo, hi, 0, 1, 2, 3, 4, 5, 6, 7); }
__device__ __forceinline__ bf16x8 pack8(float a0, float a1, float a2, float a3, float a4, float a5, float a6, float a7) {
    u32x4 p; p.x = pg8::cvtpk(a0, a1); p.y = pg8::cvtpk(a2, a3); p.z = pg8::cvtpk(a4, a5); p.w = pg8::cvtpk(a6, a7); return __builtin_bit_cast(bf16x8, p); }
#define PACK_STEP(X, s) pack8((X)[8 * (s)], (X)[8 * (s) + 1], (X)[8 * (s) + 2], (X)[8 * (s) + 3], (X)[8 * (s) + 4], (X)[8 * (s) + 5], (X)[8 * (s) + 6], (X)[8 * (s) + 7])
__device__ __forceinline__ float wave_max(float v) {
#pragma unroll
    for (int o = 1; o < 64; o <<= 1) v = fmaxf(v, __shfl_xor(v, o));
    return v;
}
struct Pre { u32x4 q[2], k[2], v[4]; };

template <int PASS> __device__ __forceinline__ void mlstm_item(const Ptrs& P, LAS unsigned char* lds, int item, int tid, int lane, int wave) {
    const bf16_t* qkvo = WSP(bf16_t, WS_QKVO); const float* gates = WSP(float, WS_GATES);
    float* Lst = WSP(float, WS_ST); float* Lns = (float*)(P.ws + WS_LN);
    LAS float* tab = (LAS float*)(lds + TAB_OFF);
    const int bh = item >> 3, g = item & 7, b = bh >> 2, h = bh & 3;
    for (int c = wave; c < 64; c += 8) {
        const size_t row = (size_t)b * S + c * 64 + lane;
        const float lfv = gates[row * 8 + 4 + h], liv = gates[row * 8 + h];
        float bs = lfv;
#pragma unroll
        for (int o = 1; o < 64; o <<= 1) { const float t = __shfl_up(bs, o); if (lane >= o) bs += t; }
        const float gm = wave_max(liv - bs), Fc = __shfl(bs, 63);
        if (lane == 0) { tab[T_F + c] = Fc; tab[T_G + c] = gm; }
    }
    __syncthreads();
    if (tid == 0) { float m = 0.f; tab[T_M] = 0.f; for (int c = 0; c < 64; ++c) { m = tab[T_F + c] + fmaxf(m, tab[T_G + c]); tab[T_M + c + 1] = m; } }
    __syncthreads();
    if (PASS == 2 && tid < 8 && tid < g) { float e = tab[T_M + 8 * (tid + 1)] - tab[T_M + 8 * g]; for (int c = 8 * (tid + 1); c < 8 * g; ++c) e += tab[T_F + c]; tab[T_COEF + tid] = expf(e); }
    {
        const int c = 8 * g + wave; const size_t row = (size_t)b * S + c * 64 + lane;
        const float lfv = gates[row * 8 + 4 + h], liv = gates[row * 8 + h];
        float bs = lfv;
#pragma unroll
        for (int o = 1; o < 64; o <<= 1) { const float t = __shfl_up(bs, o); if (lane >= o) bs += t; }
        const float gv = liv - bs; float cm = gv;
#pragma unroll
        for (int o = 1; o < 64; o <<= 1) { const float t = __shfl_up(cm, o); if (lane >= o) cm = fmaxf(cm, t); }
        const float mc = tab[T_M + c], mn = tab[T_M + c + 1], Fc = tab[T_F + c], Mt = fmaxf(mc, cm);
        const int base = T_CH + wave * 320;
        tab[base + lane] = gv * LOG2E; tab[base + 64 + lane] = Mt * LOG2E; tab[base + 128 + lane] = expf(mc - Mt);
        tab[base + 192 + lane] = expf(-(bs + Mt)); tab[base + 256 + lane] = expf(Fc + gv - mn);
        if (lane == 0) tab[T_DECAY + wave] = expf(Fc + mc - mn);
    }
    __syncthreads();
    f32x16 C[4]; float nval = 0.f;
#pragma unroll
    for (int kt = 0; kt < 4; ++kt)
#pragma unroll
        for (int r = 0; r < 16; ++r) C[kt][r] = 0.f;
    if (PASS == 2) {
        for (int gp = 0; gp < g; ++gp) {
            const float cf = tab[T_COEF + gp];
            const float* Lp = Lst + ((size_t)((bh * 8 + gp) * 8 + wave) * 64) * 64 + lane;
#pragma unroll
            for (int kt = 0; kt < 4; ++kt)
#pragma unroll
                for (int r = 0; r < 16; ++r) C[kt][r] += cf * Lp[(size_t)(kt * 16 + r) * 64];
            nval += cf * Lns[(size_t)(bh * 8 + gp) * 128 + 16 * wave + (lane & 15)];
        }
    }
    const size_t m_seg = (size_t)b * S + (size_t)g * 512;
    Pre pr;
#define ML_LOAD(cj) do { const size_t m0_ = m_seg + (size_t)(cj) * 64; int tt_ = tid; asm volatile("" : "+v"(tt_)); \
        _Pragma("unroll") for (int i_ = 0; i_ < 2; ++i_) { const int idx_ = tt_ + 512 * i_, row_ = idx_ >> 4, ch_ = idx_ & 15; const bf16_t* rp_ = qkvo + (m0_ + row_) * NIN + h * 128 + ch_ * 8; \
            if (PASS == 2) pr.q[i_] = *(const u32x4*)rp_; pr.k[i_] = *(const u32x4*)(rp_ + 512); } \
        _Pragma("unroll") for (int i_ = 0; i_ < 4; ++i_) { const int idx_ = tt_ + 512 * i_, row_ = idx_ >> 5, ch_ = idx_ & 31; pr.v[i_] = *(const u32x4*)(qkvo + (m0_ + row_) * NIN + 1024 + h * 256 + ch_ * 8); } } while (0)
#define ML_STORE(cj) do { int tt_ = tid; asm volatile("" : "+v"(tt_)); \
        _Pragma("unroll") for (int i_ = 0; i_ < 2; ++i_) { const int idx_ = tt_ + 512 * i_, row_ = idx_ >> 4, ch_ = idx_ & 15; const int sw_ = row_ * QK_STR + (ch_ << 4); \
            if (PASS == 2) { *(LAS u32x4*)(lds + Q_OFF + sw_) = pr.q[i_]; *(LAS u32x4*)(lds + K_OFF + sw_) = pr.k[i_]; } \
            const float w_ = tab[T_CH + (cj) * 320 + 256 + row_]; const unsigned kw_[4] = {pr.k[i_].x, pr.k[i_].y, pr.k[i_].z, pr.k[i_].w}; u32x4 o_; \
            o_.x = pg8::cvtpk(__uint_as_float(kw_[0] << 16) * w_, __uint_as_float(kw_[0] & 0xffff0000u) * w_); o_.y = pg8::cvtpk(__uint_as_float(kw_[1] << 16) * w_, __uint_as_float(kw_[1] & 0xffff0000u) * w_); \
            o_.z = pg8::cvtpk(__uint_as_float(kw_[2] << 16) * w_, __uint_as_float(kw_[2] & 0xffff0000u) * w_); o_.w = pg8::cvtpk(__uint_as_float(kw_[3] << 16) * w_, __uint_as_float(kw_[3] & 0xffff0000u) * w_); \
            *(LAS u32x4*)(lds + KW_OFF + row_ * KW_STR + ch_ * 16) = o_; } \
        _Pragma("unroll") for (int i_ = 0; i_ < 4; ++i_) { const int idx_ = tt_ + 512 * i_, row_ = idx_ >> 5, ch_ = idx_ & 31; *(LAS u32x4*)(lds + V_OFF + row_ * V_STR + ch_ * 16) = pr.v[i_]; } } while (0)
    ML_LOAD(0);
    for (int cj = 0; cj < 8; ++cj) {
        int lane_ = lane; asm volatile("" : "+v"(lane_));
        const int tl = lane_ & 31, hh = lane_ >> 5;
        const int i16 = lane_ & 15, tq = i16 >> 2, tp = i16 & 3, blk = (lane_ >> 4) & 1;
        const int vtr_off = V_OFF + (4 * hh + tq) * V_STR + (32 * wave + 16 * blk + 4 * tp) * 2;
        const int kwtr_off = KW_OFF + (4 * hh + tq) * KW_STR + (16 * blk + 4 * tp) * 2;
        ML_STORE(cj);
        if (PASS == 1 && cj < 7) ML_LOAD(cj + 1);
        __syncthreads();
        const int tb = T_CH + cj * 320; const float decay = tab[T_DECAY + cj];
        f32x16 num[2]; float rs0 = 0.f, rs1 = 0.f; bf16x8 pf[3][2];
        if (PASS == 2) {
            {
                const int t = lane; const LAS unsigned char* qrow = lds + Q_OFF + t * QK_STR + 32 * wave;
                const u32x4 qa = *(const LAS u32x4*)(qrow), qb = *(const LAS u32x4*)(qrow + 16);
                const unsigned qw[8] = {qa.x, qa.y, qa.z, qa.w, qb.x, qb.y, qb.z, qb.w};
                float acc = 0.f;
#pragma unroll
                for (int i = 0; i < 8; ++i) { acc += __uint_as_float(qw[i] << 16) * __shfl(nval, 2 * i); acc += __uint_as_float(qw[i] & 0xffff0000u) * __shfl(nval, 2 * i + 1); }
                tab[T_DENP + wave * 64 + t] = acc;
            }
#pragma unroll
            for (int tile = 0; tile < 3; ++tile) {
                const int i = (tile == 2) ? 1 : 0, j = (tile == 0) ? 0 : 1;
                f32x16 st;
#pragma unroll
                for (int r = 0; r < 16; ++r) st[r] = 0.f;
                const int ra = 32 * i + tl, rb = 32 * j + tl;
#pragma unroll
                for (int ks = 0; ks < 8; ++ks) {
                    const int ch = 2 * ks + hh;
                    const bf16x8 ka = *(const LAS bf16x8*)(lds + K_OFF + ra * QK_STR + (ch << 4));
                    const bf16x8 qb = *(const LAS bf16x8*)(lds + Q_OFF + rb * QK_STR + (ch << 4));
                    st = MFMA32(ka, qb, st);
                }
                const float Ml = tab[tb + 64 + 32 * j + tl];
                float rs = 0.f;
#pragma unroll
                for (int a = 0; a < 4; ++a) {
                    const f32x4 gl = *(const LAS f32x4*)(tab + tb + 32 * i + 8 * a + 4 * hh);
#pragma unroll
                    for (int q = 0; q < 4; ++q) {
                        float pv = st[4 * a + q] * __builtin_amdgcn_exp2f(gl[q] - Ml);
                        if (i == j) pv = (8 * a + 4 * hh + q <= tl) ? pv : 0.f;
                        st[4 * a + q] = pv; rs += pv;
                    }
                }
                if (j == 0) rs0 += rs; else rs1 += rs;
                pf[tile][0] = PACK_STEP(st, 0); pf[tile][1] = PACK_STEP(st, 1);
                __builtin_amdgcn_sched_barrier(0);
            }
#pragma unroll
            for (int j = 0; j < 2; ++j) {
#pragma unroll
                for (int r = 0; r < 16; ++r) num[j][r] = 0.f;
                const int row = 32 * j + tl; const LAS unsigned char* qrow = lds + Q_OFF + row * QK_STR + 8 * hh;
#pragma unroll
                for (int kt = 0; kt < 4; ++kt)
#pragma unroll
                    for (int s2 = 0; s2 < 2; ++s2) {
                        const int ch = 4 * kt + 2 * s2;
                        const s16x4 lo = *(const LAS s16x4*)(qrow + (ch << 4)), hi = *(const LAS s16x4*)(qrow + ((ch + 1) << 4));
                        num[j] = MFMA32(cat8(lo, hi), PACK_STEP(C[kt], s2), num[j]);
                    }
                __builtin_amdgcn_sched_barrier(0);
            }
            rs0 += __shfl_xor(rs0, 32); rs1 += __shfl_xor(rs1, 32);
#pragma unroll
            for (int j = 0; j < 2; ++j)
#pragma unroll
                for (int a = 0; a < 4; ++a) { const f32x4 it = *(const LAS f32x4*)(tab + tb + 128 + 32 * j + 8 * a + 4 * hh);
#pragma unroll
                    for (int q = 0; q < 4; ++q) num[j][4 * a + q] *= it[q]; }
        }
        bf16x8 vf[4];
#pragma unroll
        for (int ks = 0; ks < 4; ++ks) vf[ks] = cat8(vtr(lds + vtr_off + 16 * ks * V_STR), vtr(lds + vtr_off + (16 * ks + 8) * V_STR));
        if (PASS == 2) {
            num[0] = MFMA32(pf[0][0], vf[0], num[0]); num[0] = MFMA32(pf[0][1], vf[1], num[0]);
            num[1] = MFMA32(pf[1][0], vf[0], num[1]); num[1] = MFMA32(pf[1][1], vf[1], num[1]);
            num[1] = MFMA32(pf[2][0], vf[2], num[1]); num[1] = MFMA32(pf[2][1], vf[3], num[1]);
        }
#pragma unroll
        for (int kt = 0; kt < 4; ++kt) {
#pragma unroll
            for (int r = 0; r < 16; ++r) C[kt][r] *= decay;
#pragma unroll
            for (int ks = 0; ks < 4; ++ks) {
                const bf16x8 ka = cat8(vtr(lds + kwtr_off + 16 * ks * KW_STR + 64 * kt), vtr(lds + kwtr_off + (16 * ks + 8) * KW_STR + 64 * kt));
                C[kt] = MFMA32(ka, vf[ks], C[kt]);
            }
            __builtin_amdgcn_sched_barrier(0);
        }
        {
            const int kl = lane & 15, sq = lane >> 4; float part = 0.f;
            const LAS unsigned char* kp = lds + KW_OFF + (16 * sq) * KW_STR + (16 * wave + kl) * 2;
#pragma unroll
            for (int s = 0; s < 16; ++s) part += __uint_as_float((unsigned)(*(const LAS unsigned short*)(kp + s * KW_STR)) << 16);
            part += __shfl_xor(part, 16); part += __shfl_xor(part, 32);
            nval = decay * nval + part;
        }
        if (PASS == 2) {
            __syncthreads();
            if (cj < 7) ML_LOAD(cj + 1);
            {
                const int t = lane; float qn = 0.f;
#pragma unroll
                for (int w8 = 0; w8 < 8; ++w8) qn += tab[T_DENP + w8 * 64 + t];
                const float den = ((lane < 32) ? rs0 : rs1) + tab[tb + 128 + t] * qn;
                tab[T_HS + wave * 64 + t] = 1.0f / fmaxf(fabsf(den), tab[tb + 192 + t]);
            }
            LDS_WAIT();
#pragma unroll
            for (int j = 0; j < 2; ++j)
#pragma unroll
                for (int a = 0; a < 4; ++a) { const f32x4 hs = *(const LAS f32x4*)(tab + T_HS + wave * 64 + 32 * j + 8 * a + 4 * hh);
#pragma unroll
                    for (int q = 0; q < 4; ++q) { const int t = 32 * j + 8 * a + 4 * hh + q;
                        *(LAS float*)(lds + HST_OFF + t * HST_STR + (32 * wave + tl) * 4) = num[j][4 * a + q] * hs[q]; } }
            __syncthreads();
            {
                const f32x4 hg = *(const f32x4*)(P.a_hg + h * 256 + 4 * lane);
                bf16_t* hb = WSP(bf16_t, WS_HB);
#pragma unroll
                for (int rr = 0; rr < 8; ++rr) {
                    const int t = 8 * wave + rr; const size_t m = m_seg + (size_t)cj * 64 + t;
                    f32x4 x = *(const LAS f32x4*)(lds + HST_OFF + t * HST_STR + 16 * lane);
                    const u32x2 ow = *(const u32x2*)(qkvo + m * NIN + 2048 + h * 256 + 4 * lane);
                    const float mu = wave_sum((x[0] + x[1]) + (x[2] + x[3])) * (1.f / 256.f);
                    x = x - mu;
                    const float rstd = 1.f / sqrtf(wave_sum((x[0] * x[0] + x[1] * x[1]) + (x[2] * x[2] + x[3] * x[3])) * (1.f / 256.f) + LN_EPS);
                    const float o0 = __uint_as_float(ow.x << 16), o1 = __uint_as_float(ow.x & 0xffff0000u), o2 = __uint_as_float(ow.y << 16), o3 = __uint_as_float(ow.y & 0xffff0000u);
                    u32x2 w2; w2.x = pg8::cvtpk(pg8::fast_sigmoid(o0) * (x[0] * rstd * hg[0]), pg8::fast_sigmoid(o1) * (x[1] * rstd * hg[1]));
                    w2.y = pg8::cvtpk(pg8::fast_sigmoid(o2) * (x[2] * rstd * hg[2]), pg8::fast_sigmoid(o3) * (x[3] * rstd * hg[3]));
                    *(u32x2*)(hb + m * D + h * 256 + 4 * lane) = w2;
                }
            }
        }
        __syncthreads();
    }
#undef ML_LOAD
#undef ML_STORE
    if (PASS == 1) {
        float* Lp = Lst + ((size_t)((bh * 8 + g) * 8 + wave) * 64) * 64 + lane;
#pragma unroll
        for (int kt = 0; kt < 4; ++kt)
#pragma unroll
            for (int r = 0; r < 16; ++r) Lp[(size_t)(kt * 16 + r) * 64] = C[kt][r];
        if (lane < 16) Lns[(size_t)(bh * 8 + g) * 128 + 16 * wave + lane] = nval;
    }
}
template <int PASS> __device__ __forceinline__ void phase_mlstm(const Ptrs& P, LAS unsigned char* lds, int vcu, int G, int tid, int lane, int wave) {
    { int t_ = threadIdx.x; asm volatile("" : "+v"(t_)); tid = t_; lane = t_ & 63; wave = __builtin_amdgcn_readfirstlane(t_ >> 6); }
    for (int item = vcu; item < 256; item += G) {
        if (PASS == 1 && (item & 7) == 7) continue;
        mlstm_item<PASS>(P, lds, item, tid, lane, wave);
        __syncthreads();
    }
}
#undef MFMA32
}
namespace at {
typedef short bf16x8 __attribute__((ext_vector_type(8)));
typedef short s16x4 __attribute__((ext_vector_type(4)));
typedef float f32x16 __attribute__((ext_vector_type(16)));
typedef unsigned u32x4 __attribute__((ext_vector_type(4)));
constexpr int K_STR = 144, V_STR = 192, K_OFF = 0, V_OFF = 192 * K_STR  , SCR_OFF = V_OFF + 192 * V_STR  , SCR_PER = 4608 + 256;
constexpr float LOG2E = 1.4426950408889634f;
#define MFMA32(a, b, c) __builtin_amdgcn_mfma_f32_32x32x16_bf16((a), (b), (c), 0, 0, 0)
__device__ __forceinline__ float lo16(unsigned w) { return __uint_as_float(w << 16); }
__device__ __forceinline__ float hi16(unsigned w) { return __uint_as_float(w & 0xffff0000u); }

__device__ __forceinline__ void phase_attn(const Ptrs& P, LAS unsigned char* lds, int vcu, int G) {
    int t0_ = threadIdx.x; asm volatile("" : "+v"(t0_));
    const int tid = t0_, wave = __builtin_amdgcn_readfirstlane(t0_ >> 6);
    const bf16_t* qkv = WSP(bf16_t, WS_QKV1); const float* cs = WSP(float, WS_CS); bf16_t* ob = WSP(bf16_t, WS_OB);
    const int per = 2048 / G;
    const int hql = wave >> 1, jt = wave & 1;
    for (int ui = 0; ui < per; ++ui) {
        int lane = tid & 63; asm volatile("" : "+v"(lane));
        const int u = vcu * per + ui, b = u >> 8, kvh = (u >> 6) & 3, qb = u & 63, q0 = qb * 64;
        const size_t mb = (size_t)b * S;
        {
            int tt = tid; asm volatile("" : "+v"(tt));
            for (int idx = tt; idx < 768; idx += 512) {
                const int row = idx >> 2, pair = idx & 3, jrel = q0 - 128 + row;
                u32x4 a = {0u, 0u, 0u, 0u}, c = {0u, 0u, 0u, 0u};
                if (jrel >= 0) {
                    const bf16_t* src = qkv + (mb + jrel) * NQKV + 1024 + kvh * 64 + pair * 16;
                    a = *(const u32x4*)src; c = *(const u32x4*)(src + 8);
                    if (pair == 0) {
                        const float* cr = cs + (mb + jrel) * 16;
                        const f32x4 c0 = *(const f32x4*)cr, c1 = *(const f32x4*)(cr + 4), s0 = *(const f32x4*)(cr + 8), s1 = *(const f32x4*)(cr + 12);
                        const float cc[8] = {c0[0], c0[1], c0[2], c0[3], c1[0], c1[1], c1[2], c1[3]}, ss[8] = {s0[0], s0[1], s0[2], s0[3], s1[0], s1[1], s1[2], s1[3]};
                        const unsigned aw[4] = {a.x, a.y, a.z, a.w}, cw[4] = {c.x, c.y, c.z, c.w};
                        unsigned ao[4], co[4];
#pragma unroll
                        for (int j = 0; j < 4; ++j) {
                            const float x1a = lo16(aw[j]), x1b = hi16(aw[j]), x2a = lo16(cw[j]), x2b = hi16(cw[j]);
                            ao[j] = pg8::cvtpk(x1a * cc[2 * j] - x2a * ss[2 * j], x1b * cc[2 * j + 1] - x2b * ss[2 * j + 1]);
                            co[j] = pg8::cvtpk(x2a * cc[2 * j] + x1a * ss[2 * j], x2b * cc[2 * j + 1] + x1b * ss[2 * j + 1]);
                        }
                        a = (u32x4){ao[0], ao[1], ao[2], ao[3]}; c = (u32x4){co[0], co[1], co[2], co[3]};
                    }
                }
                *(LAS u32x4*)(lds + K_OFF + row * K_STR + pair * 32) = a; *(LAS u32x4*)(lds + K_OFF + row * K_STR + pair * 32 + 16) = c;
            }
#pragma unroll
            for (int i = 0; i < 3; ++i) {
                const int idx = tt + 512 * i, row = idx >> 3, ch = idx & 7, jrel = q0 - 128 + row;
                u32x4 v = {0u, 0u, 0u, 0u};
                if (jrel >= 0) v = *(const u32x4*)(qkv + (mb + jrel) * NQKV + 1280 + kvh * 64 + ch * 8);
                *(LAS u32x4*)(lds + V_OFF + row * V_STR + ch * 16) = v;
            }
        }
        const int r = lane & 31, hh = lane >> 5, hq = kvh * 4 + hql;
        const size_t mq = mb + q0 + 32 * jt + r;
        bf16x8 qf[4];
        {
            const bf16_t* qp = qkv + mq * NQKV + hq * 64 + 8 * hh;
#pragma unroll
            for (int ks = 0; ks < 4; ++ks) qf[ks] = *(const bf16x8*)(qp + 16 * ks);
            const float* cr = cs + mq * 16;
            const f32x4 c0 = *(const f32x4*)cr, c1 = *(const f32x4*)(cr + 4), s0 = *(const f32x4*)(cr + 8), s1 = *(const f32x4*)(cr + 12);
            const float cc[8] = {c0[0], c0[1], c0[2], c0[3], c1[0], c1[1], c1[2], c1[3]}, ss[8] = {s0[0], s0[1], s0[2], s0[3], s1[0], s1[1], s1[2], s1[3]};
            const u32x4 qw = __builtin_bit_cast(u32x4, qf[0]); const unsigned w4[4] = {qw.x, qw.y, qw.z, qw.w}; unsigned o4[4];
#pragma unroll
            for (int j = 0; j < 4; ++j) {
                const float xa = lo16(w4[j]), xb = hi16(w4[j]);
                const float ya = __shfl_xor(xa, 32), yb = __shfl_xor(xb, 32);
                const float sa = hh ? ss[2 * j] : -ss[2 * j], sb = hh ? ss[2 * j + 1] : -ss[2 * j + 1];
                o4[j] = pg8::cvtpk(xa * cc[2 * j] + ya * sa, xb * cc[2 * j + 1] + yb * sb);
            }
            qf[0] = __builtin_bit_cast(bf16x8, (u32x4){o4[0], o4[1], o4[2], o4[3]});
        }
        __syncthreads();
        f32x16 st[5];
#pragma unroll
        for (int kt = 0; kt < 5; ++kt) {
#pragma unroll
            for (int i = 0; i < 16; ++i) st[kt][i] = 0.f;
            const LAS unsigned char* kp = lds + K_OFF + (32 * (jt + kt) + r) * K_STR + 16 * hh;
#pragma unroll
            for (int ks = 0; ks < 4; ++ks) st[kt] = MFMA32(*(const LAS bf16x8*)(kp + 32 * ks), qf[ks], st[kt]);
        }
        const int tmin = (128 - q0 + 31) >> 5;
        const float snk = P.b_sinks[hq] * LOG2E;
        float mx = snk;
#pragma unroll
        for (int kt = 0; kt < 5; ++kt) {
            const bool dead = (jt + kt) < tmin;
#pragma unroll
            for (int i = 0; i < 16; ++i) {
                const int c = (i & 3) + 8 * (i >> 2) + 4 * hh;
                bool ok = !dead;
                if (kt == 0) ok = ok && (c > r);
                if (kt == 4) ok = ok && (c <= r);
                const float v = ok ? st[kt][i] * LOG2E : -INFINITY;
                st[kt][i] = v; mx = fmaxf(mx, v);
            }
        }
        mx = fmaxf(mx, __shfl_xor(mx, 32));
        float sum = 0.f;
#pragma unroll
        for (int kt = 0; kt < 5; ++kt)
#pragma unroll
            for (int i = 0; i < 16; ++i) { const float e = __builtin_amdgcn_exp2f(st[kt][i] - mx); st[kt][i] = e; sum += e; }
        sum += __shfl_xor(sum, 32);
        const float inv_l = 1.0f / (sum + __builtin_amdgcn_exp2f(snk - mx));
        LAS unsigned char* scr = lds + SCR_OFF + wave * SCR_PER;
        if (hh == 0) *(LAS float*)(scr + 4608 + 4 * r) = inv_l;
        f32x16 o[2];
#pragma unroll
        for (int dt = 0; dt < 2; ++dt)
#pragma unroll
            for (int i = 0; i < 16; ++i) o[dt][i] = 0.f;
        const int i16 = lane & 15, tq = i16 >> 2, tp = i16 & 3, blk = (lane >> 4) & 1;
        const LAS unsigned char* vp = lds + V_OFF + (32 * jt + 4 * hh + tq) * V_STR + (16 * blk + 4 * tp) * 2;
#pragma unroll
        for (int kt = 0; kt < 5; ++kt)
#pragma unroll
            for (int s2 = 0; s2 < 2; ++s2) {
                const bf16x8 pa = ml::pack8(st[kt][8 * s2], st[kt][8 * s2 + 1], st[kt][8 * s2 + 2], st[kt][8 * s2 + 3], st[kt][8 * s2 + 4], st[kt][8 * s2 + 5], st[kt][8 * s2 + 6], st[kt][8 * s2 + 7]);
#pragma unroll
                for (int dt = 0; dt < 2; ++dt) {
                    const LAS unsigned char* vq = vp + (32 * kt + 16 * s2) * V_STR + 64 * dt;
                    o[dt] = MFMA32(pa, ml::cat8(ml::vtr(vq), ml::vtr(vq + 8 * V_STR)), o[dt]);
                }
            }
        LDS_WAIT();
#pragma unroll
        for (int a = 0; a < 4; ++a) {
            const f32x4 il = *(const LAS f32x4*)(scr + 4608 + 4 * (8 * a + 4 * hh));
#pragma unroll
            for (int q = 0; q < 4; ++q) {
                const int row = 8 * a + 4 * hh + q;
#pragma unroll
                for (int dt = 0; dt < 2; ++dt) *(LAS bf16_t*)(scr + row * 144 + (32 * dt + r) * 2) = f2bf(o[dt][4 * a + q] * il[q]);
            }
        }
        LDS_WAIT();
        {
            bf16_t* op = ob + (mb + q0 + 32 * jt) * D + hq * 64;
#pragma unroll
            for (int i = 0; i < 4; ++i) { const int row = 8 * i + (lane >> 3), ch = lane & 7; *(u32x4*)(op + (size_t)row * D + ch * 8) = *(const LAS u32x4*)(scr + row * 144 + ch * 16); }
        }
        __syncthreads();
    }
}
#undef MFMA32
}
constexpr int NWAVES = 8;
constexpr int RING_OFF = 0, RING_BYTES = 131072;
constexpr int LDSCTL_OFF = RING_BYTES, MISC_OFF = LDSCTL_OFF + 320;
constexpr int LDS_BYTES = 147456;
constexpr int CW_TMO = 0, CW_CODE = 1, CW_BAR = 4096;
constexpr size_t CTL_ZERO_BYTES = 1u << 20;
#ifndef MK_ONE_LAUNCH
#define MK_ONE_LAUNCH 1
#endif
constexpr int NPHASE = 18;

struct Args { const void* in[24]; float* out; unsigned char* ws; int ph_lo, ph_hi; };

__global__ void __launch_bounds__(NWAVES * 64, 2) mk_fwd(Args args) {
    extern __shared__ __attribute__((aligned(16))) unsigned char lds_raw[];
    LAS unsigned char* lds = (LAS unsigned char*)lds_raw;
    volatile LAS unsigned* MISC = (volatile LAS unsigned*)(lds + MISC_OFF);
    const int tid = threadIdx.x, lane = tid & 63, wave = __builtin_amdgcn_readfirstlane(tid >> 6);
    const int G = gridDim.x, bx = blockIdx.x;
    const int vcu = (G % 8 == 0) ? (bx % 8) * (G / 8) + bx / 8 : bx;
    const int gw = vcu * NWAVES + wave, NGW = G * NWAVES;
    Ptrs P;
    P.x = (const float*)args.in[0]; P.p = (const float*)args.in[1]; P.pos = (const int*)args.in[2];
    P.a_w_in = (const float*)args.in[3]; P.a_b_ig = (const float*)args.in[4]; P.a_b_fg = (const float*)args.in[5]; P.a_hg = (const float*)args.in[6]; P.a_w_out = (const float*)args.in[7];
    P.kv_w = (const float*)args.in[8]; P.kv_b = (const float*)args.in[9]; P.b_w_q = (const float*)args.in[10]; P.b_b_q = (const float*)args.in[11]; P.b_sinks = (const float*)args.in[12];
    P.b_w_o = (const float*)args.in[13]; P.b_b_o = (const float*)args.in[14]; P.mix_g = (const float*)args.in[15]; P.mix_b = (const float*)args.in[16];
    P.w_up = (const float*)args.in[17]; P.w_dn = (const float*)args.in[18]; P.mlp_g = (const float*)args.in[19]; P.mlp_b = (const float*)args.in[20];
    P.w_gate = (const float*)args.in[21]; P.b_gate = (const float*)args.in[22]; P.w_proj = (const float*)args.in[23];
    P.R = args.out; P.ws = args.ws;
    gu32* ctl = (gu32*)(P.ws + WS_CTL);
    for (int u = tid; u < (LDS_BYTES - LDSCTL_OFF) / 4; u += NWAVES * 64) ((LAS unsigned*)(lds + LDSCTL_OFF))[u] = 0u;
    __syncthreads();
    XcdBarrier bar; bar.bar = (unsigned*)(ctl + CW_BAR); bar.x = 0; bar.st = nullptr;
    if (MK_ONE_LAUNCH) bar = xcd_barrier_post((unsigned*)(ctl + CW_BAR), MISC + 8);
    const int lo = args.ph_lo, hi = args.ph_hi;
#define IN(k) (lo <= (k) && (k) < hi)
#define SEAM(k) do { if (IN(k) && IN((k) + 1)) xcd_barrier(bar); } while (0)
    bf16_t* Xb = WSP(bf16_t, WS_XB); bf16_t* U = WSP(bf16_t, WS_U); bf16_t* Pb = WSP(bf16_t, WS_PB); bf16_t* Hh = WSP(bf16_t, WS_HH);
    bf16_t* QKVO = WSP(bf16_t, WS_QKVO); bf16_t* HB = WSP(bf16_t, WS_HB); bf16_t* X3b = WSP(bf16_t, WS_X3B); bf16_t* QKV1 = WSP(bf16_t, WS_QKV1); bf16_t* OB = WSP(bf16_t, WS_OB);
#define GEMM(EpiT, E, Ap, Btp, N_, K_) do { pg8::Gemm g_{}; g_.A = (Ap); g_.Bt = (Btp); g_.M = M; g_.N = (N_); g_.K = (K_); pg8::StaticOrder S_; S_.init(M, (N_), G, bx); \
        pg8::gemm_phase<EpiT, pg8::StaticOrder, true, true>(lds + RING_OFF, g_, S_, (E)); } while (0)

    if (IN(0)) { phase_prologue(P, lds, gw, NGW, lane, wave); } SEAM(0);
    if (IN(1)) {
        { pg8::EpiBf16G<0> E{}; E.O = QKVO; E.ldc = NIN; E.nscale = 512; E.scale = 0.08838834764831845f; GEMM(pg8::EpiBf16G<0>, E, Xb, WSP(bf16_t, W_IN), NIN, D); }
        { pg8::EpiBf16G<0> E{}; E.O = U; E.ldc = D; E.nscale = 0; E.scale = 1.f; GEMM(pg8::EpiBf16G<0>, E, Pb, WSP(bf16_t, W_P0), D, PLE); }
    } SEAM(1);
    if (IN(2)) { ml::phase_mlstm<1>(P, lds, vcu, G, tid, lane, wave); } SEAM(2);
    if (IN(3)) { ml::phase_mlstm<2>(P, lds, vcu, G, tid, lane, wave); } SEAM(3);
    if (IN(4)) { pg8::EpiRes E{}; E.base = P.x; E.R = P.R; E.alpha = ALPHA; GEMM(pg8::EpiRes, E, HB, WSP(bf16_t, W_OUT), D, D); } SEAM(4);
    if (IN(5)) { phase_ln(P, P.mix_g, P.mix_b, gw, NGW, lane); } SEAM(5);
    if (IN(6)) { pg8::EpiBf16G<1> E{}; E.O = Hh; E.ldc = FF; E.nscale = 0; E.scale = 1.f; GEMM(pg8::EpiBf16G<1>, E, Xb, WSP(bf16_t, W_UP0), FF, D); } SEAM(6);
    if (IN(7)) { pg8::EpiRes E{}; E.base = P.R; E.R = P.R; E.alpha = ALPHA; GEMM(pg8::EpiRes, E, Hh, WSP(bf16_t, W_DN0), D, FF); } SEAM(7);
    if (IN(8)) { phase_ln(P, P.mlp_g, P.mlp_b, gw, NGW, lane); } SEAM(8);
    if (IN(9)) { pg8::EpiPle E{}; E.R = P.R; E.bias = P.b_gate; E.U = U; E.Xb = X3b; GEMM(pg8::EpiPle, E, Xb, WSP(bf16_t, W_G0), D, D); } SEAM(9);
    if (IN(10)) {
        { pg8::EpiBf16G<0> E{}; E.O = QKV1; E.bias = WSP(float, WS_BQKV); E.ldc = NQKV; E.nscale = 1024; E.scale = 0.125f; GEMM(pg8::EpiBf16G<0>, E, X3b, WSP(bf16_t, W_QKV), NQKV, D); }
        { pg8::EpiBf16G<0> E{}; E.O = U; E.ldc = D; E.nscale = 0; E.scale = 1.f; GEMM(pg8::EpiBf16G<0>, E, Pb + (size_t)M * PLE, WSP(bf16_t, W_P1), D, PLE); }
    } SEAM(10);
    if (IN(11)) { at::phase_attn(P, lds, vcu, G); } SEAM(11);
    if (IN(12)) { pg8::EpiRes E{}; E.base = P.R; E.R = P.R; E.alpha = ALPHA; E.bias = P.b_b_o; GEMM(pg8::EpiRes, E, OB, WSP(bf16_t, W_O), D, D); } SEAM(12);
    if (IN(13)) { phase_ln(P, P.mix_g + D, P.mix_b + D, gw, NGW, lane); } SEAM(13);
    if (IN(14)) { pg8::EpiBf16G<1> E{}; E.O = Hh; E.ldc = FF; E.nscale = 0; E.scale = 1.f; GEMM(pg8::EpiBf16G<1>, E, Xb, WSP(bf16_t, W_UP1), FF, D); } SEAM(14);
    if (IN(15)) { pg8::EpiRes E{}; E.base = P.R; E.R = P.R; E.alpha = ALPHA; GEMM(pg8::EpiRes, E, Hh, WSP(bf16_t, W_DN1), D, FF); } SEAM(15);
    if (IN(16)) { phase_ln(P, P.mlp_g + D, P.mlp_b + D, gw, NGW, lane); } SEAM(16);
    if (IN(17)) { pg8::EpiPle E{}; E.R = P.R; E.bias = P.b_gate + D; E.U = U; E.Xb = nullptr; GEMM(pg8::EpiPle, E, Xb, WSP(bf16_t, W_G1), D, D); }
#undef IN
#undef SEAM
#undef GEMM
}

extern "C" void kernel_launch(void* const* d_in, const int* in_sizes, int n_in, void* d_out, int out_size, void* d_ws, size_t ws_size, hipStream_t stream) {
    static int grid = 0;
    if (grid == 0) {
        if (n_in != 24 || in_sizes[0] != M * D || out_size != M * D || ws_size < WS_END) {
            fprintf(stderr, "kernel_launch: unexpected shapes: n_in %d in0 %d out %d ws %zu; nothing launched\n", n_in, n_in > 0 ? in_sizes[0] : -1, out_size, ws_size); grid = -1; return; }
        int dev = 0, cus = 0, per_cu = 0;
        if (hipGetDevice(&dev) != hipSuccess || hipDeviceGetAttribute(&cus, hipDeviceAttributeMultiprocessorCount, dev) != hipSuccess) { fprintf(stderr, "kernel_launch: device query failed\n"); grid = -1; return; }
        if (hipFuncSetAttribute((const void*)mk_fwd, hipFuncAttributeMaxDynamicSharedMemorySize, LDS_BYTES) != hipSuccess) { fprintf(stderr, "kernel_launch: hipFuncSetAttribute failed\n"); grid = -1; return; }
        if (hipOccupancyMaxActiveBlocksPerMultiprocessor(&per_cu, (const void*)mk_fwd, NWAVES * 64, LDS_BYTES) != hipSuccess || per_cu < 1)
            fprintf(stderr, "kernel_launch: note: occupancy query reports %d workgroups per CU\n", per_cu);
        (void)hipGetLastError();
        grid = cus;
    }
    if (grid < 0) return;
    if (hipMemsetAsync((char*)d_ws + WS_CTL, 0, CTL_ZERO_BYTES, stream) != hipSuccess) { fprintf(stderr, "kernel_launch: memset failed\n"); return; }
    Args a{};
    for (int i = 0; i < 24; ++i) a.in[i] = d_in[i];
    a.out = (float*)d_out; a.ws = (unsigned char*)d_ws;
#if MK_ONE_LAUNCH
    a.ph_lo = 0; a.ph_hi = NPHASE;
    hipLaunchKernelGGL(mk_fwd, dim3(grid), dim3(NWAVES * 64), LDS_BYTES, stream, a);
#else
    for (int ph = 0; ph < NPHASE; ++ph) { a.ph_lo = ph; a.ph_hi = ph + 1; hipLaunchKernelGGL(mk_fwd, dim3(grid), dim3(NWAVES * 64), LDS_BYTES, stream, a); }
#endif
    const hipError_t le = hipPeekAtLastError();
    if (le != hipSuccess) fprintf(stderr, "kernel_launch: launch failed: %s\n", hipGetErrorName(le));
}
```
